# Optimizing an MI355X kernel written in HIP

```python
import math
import jax, jax.numpy as jnp
from jax import lax
import numpy as np

D_MODEL = 1024
BATCH = 4
SEQ = 4096
DEPTH = 4

N_MIXERS = 3
A_GROUPS = ((128, 1), (512, 4), (2048, 16))
A_HEADS = 16
A_HEAD_DIM = D_MODEL // A_HEADS
A_BLOCK = 128
NUM_BUCKETS = 32
MAX_DISTANCE = 2048
B_CHUNK = 128
B_WIDTH = 2 * D_MODEL
B_GROUPS = 16
C_HEADS = 8
C_HEAD_DIM = D_MODEL // C_HEADS
C_CONV = 4
C_CHUNK = 64
MOE_GROUPS = 8
MOE_PER_GROUP = 8
MOE_EXPERTS = MOE_GROUPS * MOE_PER_GROUP
MOE_TOPK = 2
MOE_HIDDEN = D_MODEL // 2
LN_EPS = 1e-5
RMS_EPS = 1e-6
DEEPNORM_ALPHA = (2 * DEPTH) ** 0.25
DEEPNORM_BETA = (8 * DEPTH) ** -0.25
N_A = (DEPTH + 2) // 3
N_B = (DEPTH + 1) // 3
N_C = DEPTH // 3

kernel_name = 'hybrid_dilated_sgu_deltanet_hmoe'


def layer_norm(x, g, b):
    xf = x.astype(jnp.float32)
    mu = jnp.mean(xf, axis=-1, keepdims=True)
    xc = xf - mu
    var = jnp.mean(xc * xc, axis=-1, keepdims=True)
    y = xc * lax.rsqrt(var + LN_EPS) * g.astype(jnp.float32) + b.astype(jnp.float32)
    return y.astype(x.dtype)


def t5_bucket(dist):
    max_exact = NUM_BUCKETS // 2
    d = jnp.maximum(dist, 1).astype(jnp.float32)
    large = max_exact + (jnp.log(d / max_exact) / math.log(MAX_DISTANCE / max_exact)
                         * (NUM_BUCKETS - max_exact)).astype(jnp.int32)
    return jnp.where(dist < max_exact, dist, jnp.minimum(large, NUM_BUCKETS - 1))


def _dilated_group(q, k, v, window, dil, rel_bias):
    B, S, H, Dh = q.shape
    steps = window // dil
    L = S // dil
    nb = -(-L // A_BLOCK)
    Lp = nb * A_BLOCK

    def by_residue(t):
        t = t.reshape(B, L, dil, H, Dh).transpose(0, 2, 3, 1, 4)
        return jnp.pad(t, ((0, 0), (0, 0), (0, 0), (0, Lp - L), (0, 0)))

    qr, kr, vr = by_residue(q), by_residue(k), by_residue(v)
    qb = qr.reshape(B, dil, H, nb, A_BLOCK, Dh)

    def band(t):
        prev = jnp.pad(t, ((0, 0), (0, 0), (0, 0), (A_BLOCK, 0), (0, 0)))[:, :, :, :Lp]
        return jnp.concatenate([prev.reshape(B, dil, H, nb, A_BLOCK, Dh),
                                t.reshape(B, dil, H, nb, A_BLOCK, Dh)], axis=4)

    kb, vb = band(kr), band(vr)
    s = jnp.einsum('brhnqd,brhnkd->brhnqk', qb, kb,
                   preferred_element_type=jnp.float32) * (Dh ** -0.5)
    qi = jnp.arange(A_BLOCK)[:, None]
    ki = jnp.arange(2 * A_BLOCK)[None, :]
    rel = qi + A_BLOCK - ki
    key_pos = jnp.arange(nb)[:, None, None] * A_BLOCK + ki[None] - A_BLOCK
    valid = (rel >= 0) & (rel <= steps) & (key_pos >= 0)
    bias = rel_bias[t5_bucket(jnp.maximum(rel, 0) * dil)].astype(jnp.float32)
    bias = bias.transpose(2, 0, 1)
    s = jnp.where(valid, s + bias[:, None], -jnp.inf)
    m = jnp.max(s, axis=-1, keepdims=True)
    p = jnp.exp(s - m)
    l = jnp.sum(p, axis=-1)
    o = jnp.einsum('brhnqk,brhnkd->brhnqd', p.astype(v.dtype), vb,
                   preferred_element_type=jnp.float32) / l[..., None]
    lse = m[..., 0] + jnp.log(l)
    o = o.reshape(B, dil, H, Lp, Dh)[:, :, :, :L].transpose(0, 3, 1, 2, 4).reshape(B, S, H, Dh)
    lse = lse.reshape(B, dil, H, Lp)[..., :L].transpose(0, 3, 1, 2).reshape(B, S, H)
    return o, lse


def dilated_attention(x, w_in, w_out, rel_bias):
    B, S, _ = x.shape
    G = len(A_GROUPS)
    qkv = (x @ w_in).reshape(B, S, G, 3, A_HEADS, A_HEAD_DIM)
    outs, lses = [], []
    for g, (window, dil) in enumerate(A_GROUPS):
        o, lse = _dilated_group(qkv[:, :, g, 0], qkv[:, :, g, 1], qkv[:, :, g, 2],
                                window, dil, rel_bias)
        outs.append(o)
        lses.append(lse)
    wts = jax.nn.softmax(jnp.stack(lses), axis=0)
    o = jnp.einsum('gbsh,gbshd->bshd', wts, jnp.stack(outs))
    return o.reshape(B, S, A_HEADS * A_HEAD_DIM).astype(x.dtype) @ w_out


def chunked_sgu(x, w_in, norm_g, norm_b, w_s, b_s, w_out):
    B, S, _ = x.shape
    z = jax.nn.gelu(x @ w_in)
    u, v = jnp.split(z, 2, axis=-1)
    v = layer_norm(v, norm_g, norm_b)
    n = S // B_CHUNK
    vc = v.reshape(B, n, B_CHUNK, B_GROUPS, B_WIDTH // B_GROUPS)
    w_causal = w_s * jnp.tril(jnp.ones((B_CHUNK, B_CHUNK), w_s.dtype))
    f = jnp.einsum('gts,bnsgc->bntgc', w_causal, vc) + b_s.T[:, :, None]
    return (u * f.reshape(B, S, B_WIDTH)) @ w_out


def causal_depthwise_conv(x, w):
    C = x.shape[-1]
    return lax.conv_general_dilated(x, w[:, None, :].astype(x.dtype), window_strides=(1,),
                                    padding=[(w.shape[0] - 1, 0)],
                                    dimension_numbers=('NWC', 'WIO', 'NWC'),
                                    feature_group_count=C)


def l2norm(t):
    t = t.astype(jnp.float32)
    return t * lax.rsqrt(jnp.sum(t * t, axis=-1, keepdims=True) + RMS_EPS)


def chunk_gated_delta_rule(q, k, v, g, beta):
    B, S, H, Dk = q.shape
    Dv = v.shape[-1]
    C = C_CHUNK
    N = S // C

    def chunks(t):
        return t.reshape(B, N, C, H, t.shape[-1]).transpose(1, 0, 3, 2, 4)

    q = chunks(q * (Dk ** -0.5))
    k = chunks(k)
    v = chunks(v)
    g = jnp.cumsum(g.reshape(B, N, C, H).transpose(1, 0, 3, 2), axis=-1)
    beta = beta.reshape(B, N, C, H).transpose(1, 0, 3, 2)
    kb = k * beta[..., None]
    vb = v * beta[..., None]
    tri = jnp.tril(jnp.ones((C, C), bool))
    strict = jnp.tril(jnp.ones((C, C), jnp.float32), -1)
    decay = jnp.exp(jnp.where(tri, g[..., :, None] - g[..., None, :], -jnp.inf))
    lower = jnp.einsum('nbhcd,nbhsd->nbhcs', kb, k) * decay * strict
    eye = jnp.eye(C, dtype=jnp.float32)
    t_inv = lax.linalg.triangular_solve(eye + lower, jnp.broadcast_to(eye, lower.shape),
                                        left_side=True, lower=True)
    w_val = t_inv @ vb
    k_cum = t_inv @ (kb * jnp.exp(g)[..., None])
    intra = jnp.einsum('nbhcd,nbhsd->nbhcs', q, k) * decay

    def step(state, xs):
        q_i, k_i, w_i, kc_i, g_i, a_i = xs
        v_new = w_i - kc_i @ state
        o = (q_i * jnp.exp(g_i)[..., None]) @ state + a_i @ v_new
        g_last = g_i[..., -1]
        state = state * jnp.exp(g_last)[..., None, None] + jnp.einsum(
            'bhcd,bhce->bhde', k_i * jnp.exp(g_last[..., None] - g_i)[..., None], v_new)
        return state, o

    state0 = jnp.zeros((B, H, Dk, Dv), jnp.float32)
    _, o = lax.scan(step, state0, (q, k, w_val, k_cum, g, intra))
    return o.transpose(1, 0, 3, 2, 4).reshape(B, S, H, Dv)


def gated_deltanet(x, w_in, conv_w, a_log, dt_bias, norm_w, w_out):
    B, S, _ = x.shape
    HD = C_HEADS * C_HEAD_DIM
    proj = x @ w_in
    qkv, z, b_raw, a_raw = jnp.split(proj, [3 * HD, 4 * HD, 4 * HD + C_HEADS], axis=-1)
    qkv = jax.nn.silu(causal_depthwise_conv(qkv, conv_w))
    q, k, v = [t.reshape(B, S, C_HEADS, C_HEAD_DIM) for t in jnp.split(qkv, 3, axis=-1)]
    q = l2norm(q)
    k = l2norm(k)
    beta = jax.nn.sigmoid(b_raw.astype(jnp.float32))
    g = -jnp.exp(a_log.astype(jnp.float32)) * jax.nn.softplus(
        a_raw.astype(jnp.float32) + dt_bias.astype(jnp.float32))
    o = chunk_gated_delta_rule(q, k, v.astype(jnp.float32), g, beta)
    o = o * lax.rsqrt(jnp.mean(o * o, axis=-1, keepdims=True) + RMS_EPS) * norm_w.astype(jnp.float32)
    o = o * jax.nn.silu(z.astype(jnp.float32).reshape(B, S, C_HEADS, C_HEAD_DIM))
    return o.reshape(B, S, HD).astype(x.dtype) @ w_out


def hierarchical_moe(x, w_coarse, w_fine, w_gate, w_up, w_down):
    B, S, D = x.shape
    xt = x.reshape(-1, D)
    T = xt.shape[0]
    coarse = jax.nn.softmax((xt @ w_coarse).astype(jnp.float32), axis=-1)
    p_grp, grp = lax.top_k(coarse, 1)
    fine_all = jnp.einsum('td,dge->tge', xt, w_fine).astype(jnp.float32)
    fine = fine_all[jnp.arange(T), grp[:, 0]]
    p_exp, idx = lax.top_k(jax.nn.softmax(fine, axis=-1), MOE_TOPK)
    gates = p_grp * p_exp / jnp.sum(p_exp, axis=-1, keepdims=True)
    expert = (grp * MOE_PER_GROUP + idx).reshape(-1)
    order = jnp.argsort(expert)
    tok = order // MOE_TOPK
    sizes = jnp.bincount(expert, length=MOE_EXPERTS).astype(jnp.int32)
    xs = xt[tok]
    h = jax.nn.silu(lax.ragged_dot(xs, w_gate, sizes)) * lax.ragged_dot(xs, w_up, sizes)
    y = lax.ragged_dot(h, w_down, sizes) * gates.reshape(-1)[order][:, None].astype(x.dtype)
    return jnp.zeros_like(xt).at[tok].add(y).reshape(B, S, D)


def setup_inputs(seed: int = 0) -> dict:
    key = jax.random.key(seed)
    ks = jax.random.split(key, 24)
    f32 = jnp.float32

    def nrm(k, shape, fan_in, scale=1.0):
        return jax.random.normal(k, shape, f32) * (scale * fan_in ** -0.5)

    a_qkv = 3 * len(A_GROUPS) * A_HEADS * A_HEAD_DIM
    hd_a = A_HEADS * A_HEAD_DIM
    hd_c = C_HEADS * C_HEAD_DIM
    c_in = 4 * hd_c + 2 * C_HEADS
    dt = jnp.exp(jax.random.uniform(ks[13], (N_C, C_HEADS), f32,
                                    minval=math.log(1e-3), maxval=math.log(0.1)))
    return {
        'x': jax.random.normal(ks[0], (BATCH, SEQ, D_MODEL), f32),
        'rel_bias': 0.1 * jax.random.normal(ks[1], (NUM_BUCKETS, A_HEADS), f32),
        'a_w_in': nrm(ks[2], (N_A, D_MODEL, a_qkv), D_MODEL),
        'a_w_out': nrm(ks[3], (N_A, hd_a, D_MODEL), hd_a, DEEPNORM_BETA),
        'b_w_in': nrm(ks[4], (N_B, D_MODEL, 2 * B_WIDTH), D_MODEL),
        'b_norm_g': 1.0 + 0.02 * jax.random.normal(ks[5], (N_B, B_WIDTH), f32),
        'b_norm_b': 0.02 * jax.random.normal(ks[6], (N_B, B_WIDTH), f32),
        'b_w_s': nrm(ks[7], (N_B, B_GROUPS, B_CHUNK, B_CHUNK), B_CHUNK),
        'b_b_s': 1.0 + 0.1 * jax.random.normal(ks[8], (N_B, B_GROUPS, B_CHUNK), f32),
        'b_w_out': nrm(ks[9], (N_B, B_WIDTH, D_MODEL), B_WIDTH, DEEPNORM_BETA),
        'c_w_in': nrm(ks[10], (N_C, D_MODEL, c_in), D_MODEL),
        'c_conv': nrm(ks[11], (N_C, C_CONV, 3 * hd_c), C_CONV),
        'c_a_log': jnp.log(jax.random.uniform(ks[12], (N_C, C_HEADS), f32, minval=1.0, maxval=16.0)),
        'c_dt_bias': dt + jnp.log(-jnp.expm1(-dt)),
        'c_norm_w': 1.0 + 0.02 * jax.random.normal(ks[14], (N_C, C_HEAD_DIM), f32),
        'c_w_out': nrm(ks[15], (N_C, hd_c, D_MODEL), hd_c, DEEPNORM_BETA),
        'ln_g': 1.0 + 0.02 * jax.random.normal(ks[16], (DEPTH, 2, D_MODEL), f32),
        'ln_b': 0.02 * jax.random.normal(ks[17], (DEPTH, 2, D_MODEL), f32),
        'moe_w_coarse': nrm(ks[18], (DEPTH, D_MODEL, MOE_GROUPS), D_MODEL),
        'moe_w_fine': nrm(ks[19], (DEPTH, D_MODEL, MOE_GROUPS, MOE_PER_GROUP), D_MODEL),
        'moe_w_gate': nrm(ks[20], (DEPTH, MOE_EXPERTS, D_MODEL, MOE_HIDDEN), D_MODEL),
        'moe_w_up': nrm(ks[21], (DEPTH, MOE_EXPERTS, D_MODEL, MOE_HIDDEN), D_MODEL),
        'moe_w_down': nrm(ks[22], (DEPTH, MOE_EXPERTS, MOE_HIDDEN, D_MODEL), MOE_HIDDEN, DEEPNORM_BETA),
    }


def reference(x, rel_bias, a_w_in, a_w_out, b_w_in, b_norm_g, b_norm_b, b_w_s, b_b_s, b_w_out,
              c_w_in, c_conv, c_a_log, c_dt_bias, c_norm_w, c_w_out, ln_g, ln_b,
              moe_w_coarse, moe_w_fine, moe_w_gate, moe_w_up, moe_w_down):
    for i in range(DEPTH):
        kind, j = i % N_MIXERS, i // N_MIXERS
        if kind == 0:
            h = dilated_attention(x, a_w_in[j], a_w_out[j], rel_bias)
        elif kind == 1:
            h = chunked_sgu(x, b_w_in[j], b_norm_g[j], b_norm_b[j], b_w_s[j], b_b_s[j], b_w_out[j])
        else:
            h = gated_deltanet(x, c_w_in[j], c_conv[j], c_a_log[j], c_dt_bias[j], c_norm_w[j], c_w_out[j])
        x = layer_norm(DEEPNORM_ALPHA * x + h, ln_g[i, 0], ln_b[i, 0])
        h = hierarchical_moe(x, moe_w_coarse[i], moe_w_fine[i], moe_w_gate[i], moe_w_up[i], moe_w_down[i])
        x = layer_norm(DEEPNORM_ALPHA * x + h, ln_g[i, 1], ln_b[i, 1])
    return x
```

```cpp
#include <hip/hip_runtime.h>
#include <cstdio>
#include <cstdint>

#ifndef MK_MULTI
#define MK_MULTI 1
#endif

#ifndef PH_MASK
#define PH_MASK 0xFFFF
#endif
#define PHM(b) ((PH_MASK >> (b)) & 1)
#ifndef LY_MASK
#define LY_MASK 0xF
#endif
#define LYM(b) ((LY_MASK >> (b)) & 1)
#define GAS __attribute__((address_space(1)))
#define LAS __attribute__((address_space(3)))
typedef unsigned short bf16_t;
typedef short bf16x8 __attribute__((ext_vector_type(8)));
typedef float f32x4 __attribute__((ext_vector_type(4)));
typedef float f32x2 __attribute__((ext_vector_type(2)));
typedef unsigned u32x4 __attribute__((ext_vector_type(4)));
typedef unsigned u32x2 __attribute__((ext_vector_type(2)));

constexpr int D = 1024, BATCH = 4, SEQ = 4096, T = BATCH * SEQ;
constexpr int NWAVES = 8, NTHR = 512;
constexpr int A_QKV = 9216;
constexpr int B_W = 2048;
constexpr int C_IN = 4112;
constexpr int NEXP = 64, MOE_H = 512;
constexpr float LN_EPS = 1e-5f, RMS_EPS = 1e-6f;
constexpr float ALPHA = 1.681792830507429f;

constexpr size_t MiB = 1u << 20;
constexpr size_t WS_CTL = 0, CTL_ZERO_BYTES = 1 * MiB;
constexpr size_t WS_WA_IN = 2 * MiB, WS_WA_OUT = 38 * MiB, WS_WB_IN = 42 * MiB, WS_WB_OUT = 50 * MiB, WS_WC_IN = 54 * MiB, WS_WC_OUT = 62 * MiB;
constexpr size_t WS_GU = 64 * MiB, WS_DN = 576 * MiB;
constexpr size_t WS_BIG = 832 * MiB;
constexpr size_t WS_MOE_Y = 1120 * MiB, WS_MOE_H = 1216 * MiB;
constexpr size_t WS_O = 1264 * MiB, WS_H32 = 1328 * MiB, WS_XA32 = 1392 * MiB, WS_XB32 = 1456 * MiB, WS_XABF = 1520 * MiB, WS_XBBF = 1552 * MiB;
constexpr size_t WS_ROWTOK = 1584 * MiB, WS_ROWGATE = 1588 * MiB, WS_TOKSLOT = 1592 * MiB, WS_END = 1600 * MiB;
constexpr size_t DP_WV = 0, DP_KC = 64 * MiB, DP_QG = 128 * MiB, DP_KD = 192 * MiB, DP_IN = 256 * MiB;
constexpr int CW_BAR = 4096, CW_CNT = 16384;

constexpr int SCR_BYTES = 139264;
constexpr int LCTL_OFF = SCR_BYTES;
constexpr int LDS_BYTES = 147456;
constexpr int LC_BARST = 0;
constexpr int LC_CNT = 64;
constexpr int LC_OFF = 320;
constexpr int LC_NT = 592;
constexpr int LC_TE = 640;
constexpr int LC_TR = 1408;
constexpr int LC_TL = 2176;
constexpr int LC_F0 = 3072;
constexpr int LC_F1 = 3584;
constexpr int LC_F2 = 4096;
constexpr int LC_F3 = 4608;

__device__ __forceinline__ unsigned f2bf(float f) { unsigned u = __builtin_bit_cast(unsigned, f); return (u + 0x7fffu + ((u >> 16) & 1u)) >> 16; }
__device__ __forceinline__ unsigned pk2(float lo, float hi) { return f2bf(lo) | (f2bf(hi) << 16); }
__device__ __forceinline__ float bflo(unsigned w) { return __builtin_bit_cast(float, w << 16); }
__device__ __forceinline__ float bfhi(unsigned w) { return __builtin_bit_cast(float, w & 0xffff0000u); }
__device__ __forceinline__ float bf1(bf16_t h) { return __builtin_bit_cast(float, ((unsigned)h) << 16); }
__device__ __forceinline__ float wave_sum(float v) {
#pragma unroll
    for (int o = 1; o < 64; o <<= 1) v += __shfl_xor(v, o);
    return v;
}
__device__ __forceinline__ float sigmoidf_(float x) { return 1.0f / (1.0f + __expf(-x)); }
__device__ __forceinline__ float siluf_(float x) { return x / (1.0f + __expf(-x)); }
__device__ __forceinline__ float gelu_tanh(float x) { const float u = 0.7978845608028654f * (x + 0.044715f * x * x * x); return x / (1.0f + __expf(-2.0f * u)); }
#define LDS_WAIT() asm volatile("s_waitcnt lgkmcnt(0)" ::: "memory")

#define XB_TMO      128
#define XB_XCNT(j)  (256  + 64 * (j))
#define XB_XSUB(j)  (1280 + 64 * (j))
#define XB_XGEN(j)  (2304 + 64 * (j))
#define XB_TOP      3328
#define XB_TOPGEN   3392
#define XCD_BAR_WORDS 3456
#define XB_SPIN_CAP (1u << 18)

__device__ __forceinline__ unsigned xb_ld(unsigned* p)              { return __hip_atomic_load(p, __ATOMIC_RELAXED, __HIP_MEMORY_SCOPE_AGENT); }
__device__ __forceinline__ unsigned xb_add(unsigned* p, unsigned v) { return __hip_atomic_fetch_add(p, v, __ATOMIC_RELAXED, __HIP_MEMORY_SCOPE_AGENT); }
__device__ __forceinline__ unsigned xb_xcc_id() { return (unsigned)__builtin_amdgcn_s_getreg((3 << 11) | 20) & 0xFu; }
#define XB_SPIN(cond, bar) do { unsigned _sp = 0; while (cond) { __builtin_amdgcn_s_sleep(1); \
    if ((++_sp & 255u) == 0u) { if (xb_ld(&(bar)[XB_TMO])) break; if (_sp > XB_SPIN_CAP) { atomicAdd(&(bar)[XB_TMO], 1u); break; } } } } while (0)

struct XcdBarrier { unsigned* bar; unsigned x; volatile LAS unsigned* st; };

__device__ __forceinline__ XcdBarrier xcd_barrier_post(unsigned* bar, volatile LAS unsigned* st) {
    XcdBarrier b; b.bar = bar; b.x = xb_xcc_id(); b.st = st;
    if (threadIdx.x == 0) (void)xb_add(&bar[XB_XCNT(b.x)], 1u);
    return b;
}
__device__ __forceinline__ void xcd_barrier_complete(unsigned* bar, unsigned x, unsigned& nloc, unsigned& nx) {
    const unsigned G = gridDim.x * gridDim.y * gridDim.z;
    unsigned sum, cnt, mine, sp = 0u;
    for (;;) {
        sum = 0u; cnt = 0u; mine = 0u;
#pragma unroll
        for (unsigned j = 0; j < 16; ++j) { const unsigned c = xb_ld(&bar[XB_XCNT(j)]); sum += c; cnt += (c > 0u) ? 1u : 0u; mine = (j == x) ? c : mine; }
        if (sum == G) break;
        __builtin_amdgcn_s_sleep(1);
        if ((++sp & 255u) == 0u) { if (xb_ld(&bar[XB_TMO])) break; if (sp > XB_SPIN_CAP) { atomicAdd(&bar[XB_TMO], 1u); break; } }
    }
    nloc = mine > 0u ? mine : 1u; nx = cnt > 0u ? cnt : 1u;
}
__device__ __forceinline__ void xcd_barrier(const XcdBarrier& b) {
    asm volatile("s_waitcnt vmcnt(0)" ::: "memory");
    __syncthreads();
    if (threadIdx.x == 0) {
        unsigned* bar = b.bar;
        __builtin_amdgcn_s_waitcnt(0);
        unsigned nloc = b.st[0], nx = b.st[1];
        if (nloc == 0u) { xcd_barrier_complete(bar, b.x, nloc, nx); b.st[0] = nloc; b.st[1] = nx; }
        const unsigned old = xb_add(&bar[XB_XSUB(b.x)], 1u);
        const unsigned gen = old / nloc;
        if (old + 1u == (gen + 1u) * nloc) {
            __builtin_amdgcn_fence(__ATOMIC_RELEASE, "agent");
            asm volatile("s_waitcnt vmcnt(0)" ::: "memory");
            const unsigned og = xb_add(&bar[XB_TOP], 1u);
            const unsigned tg = og / nx;
            if (og + 1u == (tg + 1u) * nx) xb_add(&bar[XB_TOPGEN], 1u);
            else XB_SPIN(xb_ld(&bar[XB_TOPGEN]) == tg, bar);
            __builtin_amdgcn_fence(__ATOMIC_ACQUIRE, "agent");
            xb_add(&bar[XB_XGEN(b.x)], 1u);
            asm volatile("s_waitcnt vmcnt(0)" ::: "memory");
        } else {
            XB_SPIN(xb_ld(&bar[XB_XGEN(b.x)]) == gen, bar);
            __builtin_amdgcn_fence(__ATOMIC_ACQUIRE, "agent");
            asm volatile("s_waitcnt vmcnt(0)" ::: "memory");
        }
    }
    __syncthreads();
}

namespace pg8 {
constexpr int BM = 256, BK = 64, HALF = 128, HTB = HALF * BK * 2, STAGE_BYTES = 8 * HTB;
__device__ __forceinline__ int lds_byte(int r, int c) { const int st = (r >> 4) * 2 + (c >> 5), rr = r & 15, cc = c & 31, ob = rr * 64 + cc * 2; return st * 1024 + (ob ^ (((ob >> 9) & 1) << 5)); }
__device__ __forceinline__ void stage_rc(int b, int& R, int& C) { const int st = b / 1024, sb = b % 1024, swz = sb ^ (((sb >> 9) & 1) << 5); R = (st >> 1) * 16 + swz / 64; C = (st & 1) * 32 + (swz % 64) / 2; }
__device__ __forceinline__ int perm32(int rho) { const int n = rho >> 4, i = rho & 15; return 8 * (i >> 2) + 4 * n + (i & 3); }
struct Unit { int pm, pn, ex, r0, l0; };
__device__ __forceinline__ unsigned cvt_pk_bf16(float lo, float hi) { unsigned r; asm volatile("v_cvt_pk_bf16_f32 %0, %1, %2" : "=v"(r) : "v"(lo), "v"(hi)); return r; }

template <class Epi, class Sched>
__device__ __forceinline__ void gemm_phase(LAS unsigned char* lds, const char* Abase, const int K, const Sched& S, const Epi& E) {
    const int tid = threadIdx.x, wid = __builtin_amdgcn_readfirstlane(tid >> 6), lane = tid & 63, wr = wid >> 2, wc = wid & 3, fr = lane & 15, fq = lane >> 4;
    const int nt = K / BK;
    int Rr[2], Cc2[2]; unsigned voffB[2];
#pragma unroll
    for (int i = 0; i < 2; ++i) { int R, C; stage_rc(tid * 16 + i * 8192, R, C); const int Rb = Epi::PERM ? ((R & ~31) + perm32(R & 31)) : R;
        Rr[i] = R; Cc2[i] = C * 2; voffB[i] = (unsigned)(Rb * K + C) * 2u; }
    const size_t kstep = (size_t)(BK * 2);
    const size_t hstep = (size_t)HALF * K * 2;
    const unsigned ldsw = (unsigned)wid * 1024u;
    const int aoff = lds_byte(wr * 64 + fr, fq * 8), boff = lds_byte(wc * 32 + fr, fq * 8);
#define PG8_SA(b, h) (((b) * 2 + (h)) * HTB)
#define PG8_SB(b, h) ((4 + (b) * 2 + (h)) * HTB)
#define PG8_STAGE2(bufoff, gbase, v0, v1) do { \
        __builtin_amdgcn_global_load_lds((const unsigned*)((const char*)(gbase) + (v0)), (LAS unsigned*)(lds + (bufoff) + ldsw), 16, 0, 0); \
        __builtin_amdgcn_global_load_lds((const unsigned*)((const char*)(gbase) + (v1)), (LAS unsigned*)(lds + (bufoff) + ldsw + 8192), 16, 0, 0); } while (0)
#define PG8_STAGEB(bufoff, gbase) PG8_STAGE2(bufoff, gbase, voffB[0], voffB[1])
#define PG8_LDA(dst, b, h) do { _Pragma("unroll") for (int m = 0; m < 4; ++m) _Pragma("unroll") for (int k = 0; k < 2; ++k) dst[m][k] = *(const LAS bf16x8*)(lds + PG8_SA(b, h) + aoff + m * 2048 + k * 1024); } while (0)
#define PG8_LDB(dst, b, h) do { _Pragma("unroll") for (int n = 0; n < 2; ++n) _Pragma("unroll") for (int k = 0; k < 2; ++k) dst[n][k] = *(const LAS bf16x8*)(lds + PG8_SB(b, h) + boff + n * 2048 + k * 1024); } while (0)
#define PG8_MMA(ai, bj, At, Bt) do { __builtin_amdgcn_s_setprio(1); _Pragma("unroll") for (int m = 0; m < 4; ++m) _Pragma("unroll") for (int n = 0; n < 2; ++n) _Pragma("unroll") for (int k = 0; k < 2; ++k) \
        acc[ai][bj][m][n] = __builtin_amdgcn_mfma_f32_16x16x32_bf16(Bt[n][k], At[m][k], acc[ai][bj][m][n], 0, 0, 0); __builtin_amdgcn_s_setprio(0); } while (0)
#define PG8_WAIT_V(n) asm volatile("s_waitcnt vmcnt(" #n ")" ::: "memory")
#define PG8_WAIT_L(n) asm volatile("s_waitcnt lgkmcnt(" #n ")" ::: "memory")
#define PG8_BAR __builtin_amdgcn_s_barrier()
#define PG8_SCHED __builtin_amdgcn_sched_barrier(0)
    Unit cur, nxt; int ui = 0;
    if (!S.next(0, cur)) return;
    f32x4 acc[2][2][4][2];
#pragma unroll
    for (int a = 0; a < 2; ++a)
#pragma unroll
        for (int b = 0; b < 2; ++b)
#pragma unroll
            for (int m = 0; m < 4; ++m)
#pragma unroll
                for (int n = 0; n < 2; ++n) acc[a][b][m][n] = (f32x4){0.f, 0.f, 0.f, 0.f};
    bf16x8 At[4][2], B0[2][2], B1[2][2];
    const char* cB = S.b_base(cur);
    unsigned va00 = S.a_off(cur, 0, Rr[0]) + Cc2[0], va01 = S.a_off(cur, 0, Rr[1]) + Cc2[1], va10 = S.a_off(cur, 1, Rr[0]) + Cc2[0], va11 = S.a_off(cur, 1, Rr[1]) + Cc2[1];
    unsigned vn00 = va00, vn01 = va01, vn10 = va10, vn11 = va11;
    PG8_STAGEB(PG8_SB(0, 0), cB); PG8_STAGE2(PG8_SA(0, 0), Abase, va00, va01); PG8_STAGEB(PG8_SB(0, 1), cB + hstep); PG8_STAGE2(PG8_SA(0, 1), Abase, va10, va11);
    if (wr == 1) PG8_BAR;
    PG8_WAIT_V(4); PG8_BAR;
    PG8_STAGEB(PG8_SB(1, 0), cB + kstep); PG8_STAGE2(PG8_SA(1, 0), Abase + kstep, va00, va01); PG8_STAGEB(PG8_SB(1, 1), cB + hstep + kstep);
    PG8_WAIT_V(6); PG8_BAR;
    for (;;) {
        const bool has_next = S.next(ui + 1, nxt);
        const char* nB = has_next ? S.b_base(nxt) : cB;
        for (int t = 0; t < nt; t += 2) {
            const bool last = (t == nt - 2);
            if (last) {
                if (has_next) { vn00 = S.a_off(nxt, 0, Rr[0]) + Cc2[0]; vn01 = S.a_off(nxt, 0, Rr[1]) + Cc2[1]; vn10 = S.a_off(nxt, 1, Rr[0]) + Cc2[0]; vn11 = S.a_off(nxt, 1, Rr[1]) + Cc2[1]; }
                else { vn00 = va00; vn01 = va01; vn10 = va10; vn11 = va11; }
            }
            const char* a1 = Abase + (size_t)(t + 1) * kstep;
            const char* a2 = last ? Abase : Abase + (size_t)(t + 2) * kstep; const char* b2 = last ? nB : cB + (size_t)(t + 2) * kstep;
            const char* a3 = a2 + kstep; const char* b3 = b2 + kstep;
            const unsigned o00 = last ? vn00 : va00, o01 = last ? vn01 : va01, o10 = last ? vn10 : va10, o11 = last ? vn11 : va11;
            PG8_LDB(B0, 0, 0); PG8_SCHED; PG8_LDA(At, 0, 0); PG8_STAGE2(PG8_SA(1, 1), a1, va10, va11);
            PG8_WAIT_L(8); PG8_BAR; PG8_WAIT_L(0); PG8_MMA(0, 0, At, B0); PG8_BAR; PG8_SCHED;
            PG8_LDB(B1, 0, 1); PG8_STAGEB(PG8_SB(0, 0), b2);
            PG8_BAR; PG8_WAIT_L(0); PG8_MMA(0, 1, At, B1); PG8_BAR;
            PG8_LDA(At, 0, 1); PG8_STAGE2(PG8_SA(0, 0), a2, o00, o01);
            PG8_BAR; PG8_WAIT_L(0); PG8_MMA(1, 0, At, B0); PG8_BAR; PG8_SCHED;
            PG8_STAGEB(PG8_SB(0, 1), b2 + hstep);
            PG8_WAIT_V(6); PG8_BAR; PG8_MMA(1, 1, At, B1); PG8_BAR;
            PG8_LDB(B0, 1, 0); PG8_SCHED; PG8_LDA(At, 1, 0); PG8_STAGE2(PG8_SA(0, 1), a2, o10, o11);
            PG8_WAIT_L(8); PG8_BAR; PG8_WAIT_L(0); PG8_MMA(0, 0, At, B0); PG8_BAR; PG8_SCHED;
            PG8_LDB(B1, 1, 1); PG8_STAGEB(PG8_SB(1, 0), b3);
            PG8_BAR; PG8_WAIT_L(0); PG8_MMA(0, 1, At, B1); PG8_BAR;
            PG8_LDA(At, 1, 1); PG8_STAGE2(PG8_SA(1, 0), a3, o00, o01);
            PG8_BAR; PG8_WAIT_L(0); PG8_MMA(1, 0, At, B0); PG8_BAR; PG8_SCHED;
            PG8_STAGEB(PG8_SB(1, 1), b3 + hstep);
            PG8_WAIT_V(6); PG8_BAR; PG8_MMA(1, 1, At, B1); PG8_BAR;
        }
        E(acc, cur, wr, wc, fr, fq);
        if (!has_next) break;
#pragma unroll
        for (int a = 0; a < 2; ++a)
#pragma unroll
            for (int b = 0; b < 2; ++b)
#pragma unroll
                for (int m = 0; m < 4; ++m)
#pragma unroll
                    for (int n = 0; n < 2; ++n) acc[a][b][m][n] = (f32x4){0.f, 0.f, 0.f, 0.f};
        cur = nxt; cB = nB; va00 = vn00; va01 = vn01; va10 = vn10; va11 = vn11; ++ui;
    }
    PG8_WAIT_V(0);
    if (wr == 0) PG8_BAR;
    PG8_BAR;
#undef PG8_SA
#undef PG8_SB
#undef PG8_STAGE2
#undef PG8_STAGEB
#undef PG8_LDA
#undef PG8_LDB
#undef PG8_MMA
#undef PG8_WAIT_V
#undef PG8_WAIT_L
#undef PG8_BAR
#undef PG8_SCHED
}

struct DenseSched {
    int nM, nN, nwg, G, c, K; const char* Bt;
    __device__ __forceinline__ void init(int M, int N, int K_, const void* Bt_, int G_, int c_) { nM = M / BM; nN = N / BM; nwg = nM * nN; G = G_; c = c_; K = K_; Bt = (const char*)Bt_; }
    __device__ __forceinline__ bool next(int i, Unit& u) const {
        const long L = (long)i * G + c; if (L >= nwg) return false;
        int wgid = (int)L; { const int q = nwg / 8, r = nwg % 8, xcd = wgid % 8, off = wgid / 8; wgid = (xcd < r ? xcd * (q + 1) : r * (q + 1) + (xcd - r) * q) + off; }
        const int nig = 8 * nN, gid = wgid / nig, fm = gid * 8, gsz = (nM - fm) < 8 ? (nM - fm) : 8;
        u.pm = fm + ((wgid % nig) % gsz); u.pn = (wgid % nig) / gsz; u.ex = 0; u.r0 = u.pm * BM; u.l0 = 0; return true;
    }
    __device__ __forceinline__ unsigned a_off(const Unit& u, int h, int R) const { return (unsigned)(u.pm * BM + h * HALF + R) * (unsigned)(K * 2); }
    __device__ __forceinline__ const char* b_base(const Unit& u) const { return Bt + (size_t)u.pn * BM * K * 2; }
};
}

struct Params { const float* in[23]; float* out; unsigned char* ws; int ph_lo, ph_hi; };

struct Frame {
    LAS unsigned char* lds;
    int tid, lane, wave, vcu, G;
    unsigned char* ws;
};

struct EpiBf16Plain {
    static constexpr bool PERM = true;
    bf16_t* O; int ldc; int act;
    __device__ __forceinline__ void operator()(const f32x4 (&acc)[2][2][4][2], const pg8::Unit& u, int wr, int wc, int fr, int fq) const {
        const int row0 = u.pm * 256 + wr * 64 + fr, col0 = u.pn * 256 + wc * 32 + 8 * fq;
#pragma unroll
        for (int ai = 0; ai < 2; ++ai)
#pragma unroll
            for (int m = 0; m < 4; ++m) { bf16_t* rowp = O + (size_t)(row0 + ai * 128 + m * 16) * ldc + col0;
#pragma unroll
                for (int bj = 0; bj < 2; ++bj) { f32x4 v0 = acc[ai][bj][m][0], v1 = acc[ai][bj][m][1];
                    if (act == 1) {
#pragma unroll
                        for (int j = 0; j < 4; ++j) { v0[j] = gelu_tanh(v0[j]); v1[j] = gelu_tanh(v1[j]); } }
                    u32x4 w; w.x = pg8::cvt_pk_bf16(v0[0], v0[1]); w.y = pg8::cvt_pk_bf16(v0[2], v0[3]); w.z = pg8::cvt_pk_bf16(v1[0], v1[1]); w.w = pg8::cvt_pk_bf16(v1[2], v1[3]);
                    *(u32x4*)(rowp + bj * 128) = w; } }
    }
};
struct EpiF32Plain {
    static constexpr bool PERM = false;
    float* C; int ldc;
    __device__ __forceinline__ void operator()(const f32x4 (&acc)[2][2][4][2], const pg8::Unit& u, int wr, int wc, int fr, int fq) const {
        const int row0 = u.pm * 256 + wr * 64 + fr, col0 = u.pn * 256 + wc * 32 + 4 * fq;
#pragma unroll
        for (int ai = 0; ai < 2; ++ai)
#pragma unroll
            for (int m = 0; m < 4; ++m) { float* rowp = C + (size_t)(row0 + ai * 128 + m * 16) * ldc + col0;
#pragma unroll
                for (int bj = 0; bj < 2; ++bj)
#pragma unroll
                    for (int n = 0; n < 2; ++n) *(f32x4*)(rowp + bj * 128 + n * 16) = acc[ai][bj][m][n]; }
    }
};
struct EpiSwiglu {
    static constexpr bool PERM = true;
    bf16_t* H;
    __device__ __forceinline__ void operator()(const f32x4 (&acc)[2][2][4][2], const pg8::Unit& u, int wr, int wc, int fr, int fq) const {
        const int row0 = u.r0 + wr * 64 + fr, col0 = u.pn * 128 + wc * 32 + 8 * fq;
#pragma unroll
        for (int ai = 0; ai < 2; ++ai)
#pragma unroll
            for (int m = 0; m < 4; ++m) { bf16_t* rowp = H + (size_t)(row0 + ai * 128 + m * 16) * MOE_H + col0;
                float o[8];
#pragma unroll
                for (int n = 0; n < 2; ++n)
#pragma unroll
                    for (int j = 0; j < 4; ++j) o[n * 4 + j] = siluf_(acc[ai][0][m][n][j]) * acc[ai][1][m][n][j];
                u32x4 w; w.x = pg8::cvt_pk_bf16(o[0], o[1]); w.y = pg8::cvt_pk_bf16(o[2], o[3]); w.z = pg8::cvt_pk_bf16(o[4], o[5]); w.w = pg8::cvt_pk_bf16(o[6], o[7]);
                *(u32x4*)rowp = w; }
    }
};
struct EpiDown {
    static constexpr bool PERM = true;
    bf16_t* Y; const float* rowgate; const LAS int* cntL;
    __device__ __forceinline__ void operator()(const f32x4 (&acc)[2][2][4][2], const pg8::Unit& u, int wr, int wc, int fr, int fq) const {
        const int lr0 = wr * 64 + fr, col0 = u.pn * 256 + wc * 32 + 8 * fq; const int cnt = cntL[u.ex];
#pragma unroll
        for (int ai = 0; ai < 2; ++ai)
#pragma unroll
            for (int m = 0; m < 4; ++m) { const int lr = lr0 + ai * 128 + m * 16; const int er = u.l0 + lr;
                const float gt = (er < cnt) ? rowgate[(size_t)u.ex * T + er] : 0.f;
                bf16_t* rowp = Y + (size_t)(u.r0 + lr) * D + col0;
#pragma unroll
                for (int bj = 0; bj < 2; ++bj) { const f32x4 v0 = acc[ai][bj][m][0] * gt, v1 = acc[ai][bj][m][1] * gt;
                    u32x4 w; w.x = pg8::cvt_pk_bf16(v0[0], v0[1]); w.y = pg8::cvt_pk_bf16(v0[2], v0[3]); w.z = pg8::cvt_pk_bf16(v1[0], v1[1]); w.w = pg8::cvt_pk_bf16(v1[2], v1[3]);
                    *(u32x4*)(rowp + bj * 128) = w; } }
    }
};

struct MoeSched1 {
    const LAS int *te, *tr, *tl, *cntL; int nunits, G, c; const int* rowtok; const char* GU;
    __device__ __forceinline__ bool next(int i, pg8::Unit& u) const { const int L = i * G + c; if (L >= nunits) return false; const int tlx = L >> 2; u.pn = L & 3; u.pm = 0; u.ex = te[tlx]; u.r0 = tr[tlx]; u.l0 = tl[tlx]; return true; }
    __device__ __forceinline__ unsigned a_off(const pg8::Unit& u, int h, int R) const { const int er = u.l0 + h * 128 + R; int tok = 0; if (er < cntL[u.ex]) tok = rowtok[(size_t)u.ex * T + er]; return (unsigned)tok * (unsigned)(D * 2); }
    __device__ __forceinline__ const char* b_base(const pg8::Unit& u) const { return GU + ((size_t)u.ex * 1024 + (size_t)u.pn * 256) * (size_t)(D * 2); }
};
struct MoeSched2 {
    const LAS int *te, *tr, *tl; int nunits, G, c; const char* DN;
    __device__ __forceinline__ bool next(int i, pg8::Unit& u) const { const int L = i * G + c; if (L >= nunits) return false; const int tlx = L >> 2; u.pn = L & 3; u.pm = 0; u.ex = te[tlx]; u.r0 = tr[tlx]; u.l0 = tl[tlx]; return true; }
    __device__ __forceinline__ unsigned a_off(const pg8::Unit& u, int h, int R) const { return (unsigned)(u.r0 + h * 128 + R) * (unsigned)(MOE_H * 2); }
    __device__ __forceinline__ const char* b_base(const pg8::Unit& u) const { return DN + ((size_t)u.ex * 1024 + (size_t)u.pn * 256) * (size_t)(MOE_H * 2); }
};

__device__ __forceinline__ void moe_tables(Frame& F, int layer) {
    LAS int* cntL = (LAS int*)(F.lds + LCTL_OFF + LC_CNT); LAS int* offL = (LAS int*)(F.lds + LCTL_OFF + LC_OFF); LAS int* ntL = (LAS int*)(F.lds + LCTL_OFF + LC_NT);
    LAS int* te = (LAS int*)(F.lds + LCTL_OFF + LC_TE); LAS int* tr = (LAS int*)(F.lds + LCTL_OFF + LC_TR); LAS int* tl = (LAS int*)(F.lds + LCTL_OFF + LC_TL);
    unsigned* cg = (unsigned*)(F.ws + WS_CTL) + CW_CNT + layer * 64;
    __syncthreads();
    if (F.tid < 64) cntL[F.tid] = (int)__hip_atomic_load(cg + F.tid, __ATOMIC_RELAXED, __HIP_MEMORY_SCOPE_AGENT);
    __syncthreads();
    if (F.tid == 0) {
        int o = 0, nt = 0;
        for (int e = 0; e < NEXP; ++e) { offL[e] = o; const int n = (cntL[e] + 255) >> 8;
            for (int t = 0; t < n; ++t) { if (nt < 192) { te[nt] = e; tr[nt] = o + 256 * t; tl[nt] = 256 * t; } ++nt; }
            o += n * 256; }
        offL[64] = o; ntL[0] = nt < 192 ? nt : 192;
    }
    __syncthreads();
}

__device__ __forceinline__ void tr_item(const float* W, int ldw, int nblk, bf16_t* WT, int Kd, int mode, LAS float* scr, int item, int lane) {
    const int kb = item / nblk, nb = item % nblk, k0 = 64 * kb, n0 = 32 * nb;
#pragma unroll 8
    for (int i = 0; i < 32; ++i) { const int kk = 2 * i + (lane >> 5); scr[kk * 33 + (lane & 31)] = W[(size_t)(k0 + kk) * ldw + n0 + (lane & 31)]; }
    LDS_WAIT(); asm volatile("" ::: "memory");
    const int c = lane & 7;
    int rbase = n0;
    if (mode == 1) rbase = (n0 >> 7) * 256 + (n0 & 127);
    if (mode == 2) rbase = (n0 >> 7) * 256 + 128 + (n0 & 127);
#pragma unroll
    for (int j = 0; j < 4; ++j) { const int n = (lane >> 3) + 8 * j; const LAS float* s = scr + (8 * c) * 33 + n;
        u32x4 o; o.x = pk2(s[0 * 33], s[1 * 33]); o.y = pk2(s[2 * 33], s[3 * 33]); o.z = pk2(s[4 * 33], s[5 * 33]); o.w = pk2(s[6 * 33], s[7 * 33]);
        *(u32x4*)(WT + (size_t)(rbase + n) * Kd + k0 + 8 * c) = o; }
    LDS_WAIT(); asm volatile("" ::: "memory");
}
__device__ __forceinline__ void phase_prologue(Frame& F, const Params& p) {
    LAS float* scr = (LAS float*)(F.lds + F.wave * 16384);
    const int gw = F.vcu * NWAVES + F.wave, NGW = F.G * NWAVES;
    constexpr int I_AIN = 16 * 288, I_AOUT = 512, I_BIN = 2048, I_BOUT = 1024, I_CIN = 2048, I_COUT = 512, I_ME = 256;
    constexpr int N_SMALL = 2 * I_AIN + 2 * I_AOUT + I_BIN + I_BOUT + I_CIN + I_COUT;
    constexpr int N_MOE = 4 * 64 * 3 * I_ME;
    unsigned char* ws = F.ws;
    for (int it = gw; it < N_SMALL + N_MOE; it += NGW) {
        int r = it;
        if (r < 2 * I_AIN) { const int j = r / I_AIN; r -= j * I_AIN; tr_item(p.in[2] + (size_t)j * D * A_QKV, A_QKV, 288, (bf16_t*)(ws + WS_WA_IN) + (size_t)j * A_QKV * D, D, 0, scr, r, F.lane); continue; } r -= 2 * I_AIN;
        if (r < 2 * I_AOUT) { const int j = r / I_AOUT; r -= j * I_AOUT; tr_item(p.in[3] + (size_t)j * D * D, D, 32, (bf16_t*)(ws + WS_WA_OUT) + (size_t)j * D * D, D, 0, scr, r, F.lane); continue; } r -= 2 * I_AOUT;
        if (r < I_BIN) { tr_item(p.in[4], 4096, 128, (bf16_t*)(ws + WS_WB_IN), D, 0, scr, r, F.lane); continue; } r -= I_BIN;
        if (r < I_BOUT) { tr_item(p.in[9], D, 32, (bf16_t*)(ws + WS_WB_OUT), B_W, 0, scr, r, F.lane); continue; } r -= I_BOUT;
        if (r < I_CIN) { tr_item(p.in[10], C_IN, 128, (bf16_t*)(ws + WS_WC_IN), D, 0, scr, r, F.lane); continue; } r -= I_CIN;
        if (r < I_COUT) { tr_item(p.in[15], D, 32, (bf16_t*)(ws + WS_WC_OUT), D, 0, scr, r, F.lane); continue; } r -= I_COUT;
        const int le = r / (3 * I_ME); r -= le * 3 * I_ME;
        if (r < I_ME) { tr_item(p.in[20] + (size_t)le * D * MOE_H, MOE_H, 16, (bf16_t*)(ws + WS_GU) + (size_t)le * 1024 * D, D, 1, scr, r, F.lane); continue; } r -= I_ME;
        if (r < I_ME) { tr_item(p.in[21] + (size_t)le * D * MOE_H, MOE_H, 16, (bf16_t*)(ws + WS_GU) + (size_t)le * 1024 * D, D, 2, scr, r, F.lane); continue; } r -= I_ME;
        tr_item(p.in[22] + (size_t)le * MOE_H * D, D, 32, (bf16_t*)(ws + WS_DN) + (size_t)le * 1024 * MOE_H, MOE_H, 0, scr, r, F.lane);
    }
    const float* x = p.in[0]; bf16_t* xb = (bf16_t*)(ws + WS_XBBF);
    for (int m = gw; m < T; m += NGW) {
        const f32x4* xr = (const f32x4*)(x + (size_t)m * D) + F.lane; u32x2* o = (u32x2*)(xb + (size_t)m * D) + F.lane;
#pragma unroll
        for (int j = 0; j < 4; ++j) { const f32x4 v = xr[64 * j]; u32x2 w; w.x = pk2(v[0], v[1]); w.y = pk2(v[2], v[3]); o[64 * j] = w; }
    }
}

__device__ __forceinline__ int t5_bucket(int d) {
    if (d < 16) return d;
    return 16 + (d >= 22) + (d >= 30) + (d >= 40) + (d >= 54) + (d >= 73) + (d >= 99) + (d >= 134) + (d >= 182) + (d >= 246) + (d >= 332) + (d >= 450) + (d >= 609) + (d >= 825) + (d >= 1117) + (d >= 1513);
}
__device__ __forceinline__ void phase_attn_naive(Frame& F, const bf16_t* qkv, bf16_t* O, const float* rel_bias) {
    LAS float* tab = (LAS float*)F.lds;
    __syncthreads();
    for (int idx = F.tid; idx < 3 * 129 * 16; idx += NTHR) { const int g = idx / (129 * 16), j = (idx >> 4) % 129, h = idx & 15; const int dil = g == 0 ? 1 : (g == 1 ? 4 : 16);
        tab[idx] = rel_bias[t5_bucket(j * dil) * 16 + h]; }
    __syncthreads();
    for (int blk = F.vcu; blk < T / 16; blk += F.G) {
        const int tok = blk * 16 + (F.tid >> 5), h = (F.tid >> 1) & 15, hf = F.tid & 1; const int pos = tok & (SEQ - 1);
        float mx = -1e30f, l = 0.f; float o[32];
#pragma unroll
        for (int d = 0; d < 32; ++d) o[d] = 0.f;
        for (int g = 0; g < 3; ++g) {
            const int dil = g == 0 ? 1 : (g == 1 ? 4 : 16);
            const bf16_t* qp = qkv + (size_t)tok * A_QKV + g * 3072 + h * 64 + hf * 32;
            float q[32];
#pragma unroll
            for (int c = 0; c < 4; ++c) { const u32x4 w = *(const u32x4*)(qp + 8 * c);
                q[8 * c + 0] = bflo(w.x) * 0.125f; q[8 * c + 1] = bfhi(w.x) * 0.125f; q[8 * c + 2] = bflo(w.y) * 0.125f; q[8 * c + 3] = bfhi(w.y) * 0.125f;
                q[8 * c + 4] = bflo(w.z) * 0.125f; q[8 * c + 5] = bfhi(w.z) * 0.125f; q[8 * c + 6] = bflo(w.w) * 0.125f; q[8 * c + 7] = bfhi(w.w) * 0.125f; }
            const int lq = pos / dil; const int nk = lq < 128 ? lq : 128;
            for (int j = 0; j <= nk; ++j) {
                const bf16_t* kp = qkv + (size_t)(tok - j * dil) * A_QKV + g * 3072 + 1024 + h * 64 + hf * 32; const bf16_t* vp = kp + 1024;
                float s = 0.f;
#pragma unroll
                for (int c = 0; c < 4; ++c) { const u32x4 w = *(const u32x4*)(kp + 8 * c);
                    s += q[8 * c + 0] * bflo(w.x) + q[8 * c + 1] * bfhi(w.x) + q[8 * c + 2] * bflo(w.y) + q[8 * c + 3] * bfhi(w.y)
                       + q[8 * c + 4] * bflo(w.z) + q[8 * c + 5] * bfhi(w.z) + q[8 * c + 6] * bflo(w.w) + q[8 * c + 7] * bfhi(w.w); }
                s += __shfl_xor(s, 1);
                s += tab[(g * 129 + j) * 16 + h];
                const float mn = fmaxf(mx, s); const float a = __expf(mx - mn), pp = __expf(s - mn); mx = mn; l = l * a + pp;
#pragma unroll
                for (int c = 0; c < 4; ++c) { const u32x4 w = *(const u32x4*)(vp + 8 * c);
                    o[8 * c + 0] = o[8 * c + 0] * a + pp * bflo(w.x); o[8 * c + 1] = o[8 * c + 1] * a + pp * bfhi(w.x); o[8 * c + 2] = o[8 * c + 2] * a + pp * bflo(w.y); o[8 * c + 3] = o[8 * c + 3] * a + pp * bfhi(w.y);
                    o[8 * c + 4] = o[8 * c + 4] * a + pp * bflo(w.z); o[8 * c + 5] = o[8 * c + 5] * a + pp * bfhi(w.z); o[8 * c + 6] = o[8 * c + 6] * a + pp * bflo(w.w); o[8 * c + 7] = o[8 * c + 7] * a + pp * bfhi(w.w); }
            }
        }
        const float il = 1.0f / l; bf16_t* op = O + (size_t)tok * D + h * 64 + hf * 32;
#pragma unroll
        for (int c = 0; c < 4; ++c) { u32x4 w; w.x = pk2(o[8 * c] * il, o[8 * c + 1] * il); w.y = pk2(o[8 * c + 2] * il, o[8 * c + 3] * il); w.z = pk2(o[8 * c + 4] * il, o[8 * c + 5] * il); w.w = pk2(o[8 * c + 6] * il, o[8 * c + 7] * il);
            *(u32x4*)(op + 8 * c) = w; }
    }
}

__device__ __forceinline__ void phase_sgu_naive(Frame& F, const bf16_t* z, bf16_t* O2, const float* gam, const float* bet, const float* w_s, const float* b_s) {
    LAS float* Vs = (LAS float*)F.lds;
    LAS float* Ws = (LAS float*)(F.lds + 65536);
    LAS float* mu = (LAS float*)(F.lds + LCTL_OFF + LC_F0); LAS float* rs = (LAS float*)(F.lds + LCTL_OFF + LC_F1);
    for (int u = F.vcu; u < 256; u += F.G) {
        const int chunk = u >> 1, gh = u & 1; const int tok0 = chunk * 128;
        __syncthreads();
        for (int r = F.wave; r < 128; r += NWAVES) {
            const bf16_t* vp = z + (size_t)(tok0 + r) * 4096 + 2048; float v[32]; float s = 0.f;
#pragma unroll
            for (int i = 0; i < 4; ++i) { const u32x4 w = *(const u32x4*)(vp + F.lane * 8 + 512 * i);
                v[8 * i + 0] = bflo(w.x); v[8 * i + 1] = bfhi(w.x); v[8 * i + 2] = bflo(w.y); v[8 * i + 3] = bfhi(w.y); v[8 * i + 4] = bflo(w.z); v[8 * i + 5] = bfhi(w.z); v[8 * i + 6] = bflo(w.w); v[8 * i + 7] = bfhi(w.w); }
#pragma unroll
            for (int i = 0; i < 32; ++i) s += v[i];
            const float mean = wave_sum(s) * (1.0f / 2048.0f); float s2 = 0.f;
#pragma unroll
            for (int i = 0; i < 32; ++i) { const float d = v[i] - mean; s2 += d * d; }
            const float var = wave_sum(s2) * (1.0f / 2048.0f);
            if (F.lane == 0) { mu[r] = mean; rs[r] = 1.0f / sqrtf(var + LN_EPS); }
        }
        __syncthreads();
        for (int gg = 0; gg < 8; ++gg) {
            const int g = gh * 8 + gg;
            for (int i = 0; i < 32; ++i) { const int idx = F.tid + NTHR * i; const int s = idx >> 7, c = idx & 127;
                const float v = bf1(z[(size_t)(tok0 + s) * 4096 + 2048 + g * 128 + c]);
                Vs[idx] = (v - mu[s]) * rs[s] * gam[g * 128 + c] + bet[g * 128 + c];
                const int t = idx >> 7, s2 = idx & 127;
                Ws[t * 129 + s2] = (s2 <= t) ? w_s[(size_t)g * 16384 + idx] : 0.f; }
            __syncthreads();
            const int t = F.tid >> 2, c0 = (F.tid & 3) * 32;
            float acc[32];
#pragma unroll
            for (int i = 0; i < 32; ++i) acc[i] = 0.f;
            for (int s = 0; s <= t; ++s) { const float w = Ws[t * 129 + s];
#pragma unroll
                for (int i = 0; i < 32; ++i) acc[i] += w * Vs[s * 128 + c0 + i]; }
            const float bs = b_s[g * 128 + t];
            const bf16_t* up = z + (size_t)(tok0 + t) * 4096 + g * 128 + c0; bf16_t* op = O2 + (size_t)(tok0 + t) * B_W + g * 128 + c0;
#pragma unroll
            for (int c = 0; c < 4; ++c) { const u32x4 w = *(const u32x4*)(up + 8 * c); u32x4 o;
                o.x = pk2(bflo(w.x) * (acc[8 * c + 0] + bs), bfhi(w.x) * (acc[8 * c + 1] + bs)); o.y = pk2(bflo(w.y) * (acc[8 * c + 2] + bs), bfhi(w.y) * (acc[8 * c + 3] + bs));
                o.z = pk2(bflo(w.z) * (acc[8 * c + 4] + bs), bfhi(w.z) * (acc[8 * c + 5] + bs)); o.w = pk2(bflo(w.w) * (acc[8 * c + 6] + bs), bfhi(w.w) * (acc[8 * c + 7] + bs));
                *(u32x4*)(op + 8 * c) = o; }
            __syncthreads();
        }
    }
}

__device__ __forceinline__ void phase_delta_pre(Frame& F, const Params& p, const bf16_t* proj, const float* x32) {
    LAS float* Qs = (LAS float*)F.lds; LAS float* Ks = Qs + 64 * 129; LAS float* Vs = Ks + 64 * 129; LAS float* Ls = Vs + 64 * 129;
    LAS float* betaL = (LAS float*)(F.lds + LCTL_OFF + LC_F0); LAS float* gL = (LAS float*)(F.lds + LCTL_OFF + LC_F1); LAS float* gcL = (LAS float*)(F.lds + LCTL_OFF + LC_F2);
    const float* w_in = p.in[10]; const float* conv = p.in[11]; const float* a_log = p.in[12]; const float* dt_bias = p.in[13];
    float* WV = (float*)(F.ws + WS_BIG + DP_WV); float* KC = (float*)(F.ws + WS_BIG + DP_KC); float* QG = (float*)(F.ws + WS_BIG + DP_QG); float* KD = (float*)(F.ws + WS_BIG + DP_KD); float* IN = (float*)(F.ws + WS_BIG + DP_IN);
    float* EGL = (float*)(F.ws + WS_ROWTOK);
    for (int u = F.vcu; u < 2048; u += F.G) {
        const int b = u >> 9, h = (u >> 6) & 7, n = u & 63; const int ch = (b * 8 + h) * 64 + n; const int tok0 = b * SEQ + n * 64;
        __syncthreads();
        { float wb[16], wa[16];
#pragma unroll
          for (int j = 0; j < 4; ++j)
#pragma unroll
              for (int i = 0; i < 4; ++i) { const int k = 4 * F.lane + 256 * j + i; wb[4 * j + i] = w_in[(size_t)k * C_IN + 4096 + h]; wa[4 * j + i] = w_in[(size_t)k * C_IN + 4104 + h]; }
#pragma unroll 1
          for (int tt = 0; tt < 8; ++tt) { const int t = F.wave * 8 + tt; const f32x4* xr = (const f32x4*)(x32 + (size_t)(tok0 + t) * D) + F.lane; float sb = 0.f, sa = 0.f;
#pragma unroll
              for (int j = 0; j < 4; ++j) { const f32x4 v = xr[64 * j];
#pragma unroll
                  for (int i = 0; i < 4; ++i) { sb += v[i] * wb[4 * j + i]; sa += v[i] * wa[4 * j + i]; } }
              sb = wave_sum(sb); sa = wave_sum(sa);
              if (F.lane == 0) { betaL[t] = sigmoidf_(sb); const float xx = sa + dt_bias[h]; const float sp = xx > 20.f ? xx : log1pf(__expf(xx)); gL[t] = -__expf(a_log[h]) * sp; } }
        }
#pragma unroll 1
        for (int i = 0; i < 48; ++i) { const int idx = F.tid + NTHR * i; const int which = idx >> 13, t = (idx >> 7) & 63, c = idx & 127; const int col = which * 1024 + h * 128 + c;
            float acc = 0.f;
#pragma unroll
            for (int j = 0; j < 4; ++j) { const int pp = n * 64 + t - 3 + j; if (pp >= 0) acc += conv[j * 3072 + col] * bf1(proj[(size_t)(b * SEQ + pp) * 4096 + col]); }
            const float v = siluf_(acc);
            (which == 0 ? Qs : (which == 1 ? Ks : Vs))[t * 129 + c] = v; }
        __syncthreads();
        if (F.tid == 0) { float s = 0.f; for (int t = 0; t < 64; ++t) { s += gL[t]; gcL[t] = s; } }
#pragma unroll 1
        for (int rr = 0; rr < 16; ++rr) { const int row = F.wave * 16 + rr; LAS float* base = (row < 64 ? Qs + row * 129 : Ks + (row - 64) * 129);
            const float x0 = base[F.lane], x1 = base[F.lane + 64]; const float ss = wave_sum(x0 * x0 + x1 * x1); float sc = 1.0f / sqrtf(ss + RMS_EPS); if (row < 64) sc *= 0.08838834764831845f;
            base[F.lane] = x0 * sc; base[F.lane + 64] = x1 * sc; }
        __syncthreads();
#pragma unroll 1
        for (int i = 0; i < 8; ++i) { const int idx = F.tid + NTHR * i; const int c = idx >> 6, s = idx & 63; float kk = 0.f, qk = 0.f;
#pragma unroll 8
            for (int d = 0; d < 128; ++d) { const float ks = Ks[s * 129 + d]; kk += Ks[c * 129 + d] * ks; qk += Qs[c * 129 + d] * ks; }
            const float dec = __expf(gcL[c] - gcL[s]);
            Ls[c * 65 + s] = (s < c) ? betaL[c] * kk * dec : 0.f;
            IN[(size_t)ch * 4096 + idx] = (s <= c) ? qk * dec : 0.f; }
#pragma unroll 1
        for (int i = 0; i < 16; ++i) { const int idx = F.tid + NTHR * i; const int c = idx >> 7, d = idx & 127;
            QG[(size_t)ch * 8192 + idx] = Qs[c * 129 + d] * __expf(gcL[c]); KD[(size_t)ch * 8192 + idx] = Ks[c * 129 + d] * __expf(gcL[63] - gcL[c]); }
        if (F.tid == 0) EGL[ch] = __expf(gcL[63]);
        __syncthreads();
#pragma unroll 1
        for (int i = 0; i < 16; ++i) { const int idx = F.tid + NTHR * i; const int c = idx >> 7, d = idx & 127; Vs[c * 129 + d] *= betaL[c]; Ks[c * 129 + d] *= betaL[c] * __expf(gcL[c]); }
        __syncthreads();
        if (F.tid < 256) { const int col = F.tid & 127; LAS float* buf = F.tid < 128 ? Vs : Ks;
#pragma unroll 1
            for (int c = 1; c < 64; ++c) { float a = buf[c * 129 + col];
#pragma unroll 4
                for (int s = 0; s < c; ++s) a -= Ls[c * 65 + s] * buf[s * 129 + col]; buf[c * 129 + col] = a; }
            float* dst = (F.tid < 128 ? WV : KC) + (size_t)ch * 8192;
#pragma unroll 4
            for (int c = 0; c < 64; ++c) dst[c * 128 + col] = buf[c * 129 + col]; }
    }
}
__device__ __forceinline__ void phase_delta_scan(Frame& F, float* oraw) {
    LAS float* KCs = (LAS float*)F.lds; LAS float* QGs = KCs + 64 * 132; LAS float* KDs = QGs + 64 * 132; LAS float* INs = KDs + 64 * 132;
    LAS float* St = INs + 64 * 68; LAS float* WVs = St + 128 * 16; LAS float* VN = WVs + 64 * 16;
    const float* WV = (const float*)(F.ws + WS_BIG + DP_WV); const float* KC = (const float*)(F.ws + WS_BIG + DP_KC); const float* QG = (const float*)(F.ws + WS_BIG + DP_QG);
    const float* KD = (const float*)(F.ws + WS_BIG + DP_KD); const float* IN = (const float*)(F.ws + WS_BIG + DP_IN); const float* EGL = (const float*)(F.ws + WS_ROWTOK);
    for (int u = F.vcu; u < 256; u += F.G) {
        const int bh = u >> 3, dv0 = (u & 7) * 16; const int b = bh >> 3, h = bh & 7;
        __syncthreads();
        for (int i = F.tid; i < 128 * 16; i += NTHR) St[i] = 0.f;
        for (int n = 0; n < 64; ++n) {
            const int ch = bh * 64 + n;
            __syncthreads();
            for (int i = 0; i < 4; ++i) { const int idx = F.tid + NTHR * i; const int c = idx >> 5, d4 = (idx & 31) * 4;
                *(LAS f32x4*)(KCs + c * 132 + d4) = *(const f32x4*)(KC + (size_t)ch * 8192 + c * 128 + d4);
                *(LAS f32x4*)(QGs + c * 132 + d4) = *(const f32x4*)(QG + (size_t)ch * 8192 + c * 128 + d4);
                *(LAS f32x4*)(KDs + c * 132 + d4) = *(const f32x4*)(KD + (size_t)ch * 8192 + c * 128 + d4); }
            for (int i = 0; i < 2; ++i) { const int idx = F.tid + NTHR * i; const int c = idx >> 4, s4 = (idx & 15) * 4; *(LAS f32x4*)(INs + c * 68 + s4) = *(const f32x4*)(IN + (size_t)ch * 4096 + c * 64 + s4); }
            if (F.tid < 256) { const int c = F.tid >> 2, j4 = (F.tid & 3) * 4; *(LAS f32x4*)(WVs + c * 16 + j4) = *(const f32x4*)(WV + (size_t)ch * 8192 + c * 128 + dv0 + j4); }
            const float egl = EGL[ch];
            __syncthreads();
            const int c = F.tid >> 3, j0 = (F.tid & 7) * 2;
            { float a0 = WVs[c * 16 + j0], a1 = WVs[c * 16 + j0 + 1];
              for (int d = 0; d < 128; ++d) { const float kc = KCs[c * 132 + d]; a0 -= kc * St[d * 16 + j0]; a1 -= kc * St[d * 16 + j0 + 1]; }
              VN[c * 16 + j0] = a0; VN[c * 16 + j0 + 1] = a1; }
            __syncthreads();
            { float o0 = 0.f, o1 = 0.f;
              for (int d = 0; d < 128; ++d) { const float qg = QGs[c * 132 + d]; o0 += qg * St[d * 16 + j0]; o1 += qg * St[d * 16 + j0 + 1]; }
              for (int s = 0; s < 64; ++s) { const float a = INs[c * 68 + s]; o0 += a * VN[s * 16 + j0]; o1 += a * VN[s * 16 + j0 + 1]; }
              float* op = oraw + (size_t)(b * SEQ + n * 64 + c) * D + h * 128 + dv0 + j0; *(f32x2*)op = (f32x2){o0, o1}; }
            const int d = F.tid >> 2, q0 = (F.tid & 3) * 4;
            float s0 = St[d * 16 + q0] * egl, s1 = St[d * 16 + q0 + 1] * egl, s2 = St[d * 16 + q0 + 2] * egl, s3 = St[d * 16 + q0 + 3] * egl;
            for (int cc = 0; cc < 64; ++cc) { const float kd = KDs[cc * 132 + d]; s0 += kd * VN[cc * 16 + q0]; s1 += kd * VN[cc * 16 + q0 + 1]; s2 += kd * VN[cc * 16 + q0 + 2]; s3 += kd * VN[cc * 16 + q0 + 3]; }
            __syncthreads();
            St[d * 16 + q0] = s0; St[d * 16 + q0 + 1] = s1; St[d * 16 + q0 + 2] = s2; St[d * 16 + q0 + 3] = s3;
        }
    }
}
__device__ __forceinline__ void phase_delta_gate(Frame& F, const float* oraw, const bf16_t* proj, const float* norm_w, bf16_t* O) {
    const int gw = F.vcu * NWAVES + F.wave, NGW = F.G * NWAVES;
    for (int m = gw; m < T; m += NGW) {
        const f32x4* op = (const f32x4*)(oraw + (size_t)m * D + 16 * F.lane); float o[16];
#pragma unroll
        for (int i = 0; i < 4; ++i) { const f32x4 v = op[i]; o[4 * i] = v[0]; o[4 * i + 1] = v[1]; o[4 * i + 2] = v[2]; o[4 * i + 3] = v[3]; }
        float ss = 0.f;
#pragma unroll
        for (int i = 0; i < 16; ++i) ss += o[i] * o[i];
        ss += __shfl_xor(ss, 1); ss += __shfl_xor(ss, 2); ss += __shfl_xor(ss, 4);
        const float r = 1.0f / sqrtf(ss * (1.0f / 128.0f) + RMS_EPS);
        const bf16_t* zp = proj + (size_t)m * 4096 + 3072 + 16 * F.lane; const u32x4 z0 = *(const u32x4*)zp, z1 = *(const u32x4*)(zp + 8);
        const float zz[16] = {bflo(z0.x), bfhi(z0.x), bflo(z0.y), bfhi(z0.y), bflo(z0.z), bfhi(z0.z), bflo(z0.w), bfhi(z0.w), bflo(z1.x), bfhi(z1.x), bflo(z1.y), bfhi(z1.y), bflo(z1.z), bfhi(z1.z), bflo(z1.w), bfhi(z1.w)};
        const int cb = (16 * F.lane) & 127; float y[16];
#pragma unroll
        for (int i = 0; i < 16; ++i) y[i] = o[i] * r * norm_w[cb + i] * siluf_(zz[i]);
        u32x4 w0, w1; w0.x = pk2(y[0], y[1]); w0.y = pk2(y[2], y[3]); w0.z = pk2(y[4], y[5]); w0.w = pk2(y[6], y[7]); w1.x = pk2(y[8], y[9]); w1.y = pk2(y[10], y[11]); w1.z = pk2(y[12], y[13]); w1.w = pk2(y[14], y[15]);
        bf16_t* dst = O + (size_t)m * D + 16 * F.lane; *(u32x4*)dst = w0; *(u32x4*)(dst + 8) = w1;
    }
}

__device__ __forceinline__ void phase_ln1_route(Frame& F, const Params& p, int layer, const float* xin, const float* h32, float* x1, bf16_t* x1b) {
    const int gw = F.vcu * NWAVES + F.wave, NGW = F.G * NWAVES;
    const float* g = p.in[16] + (size_t)(layer * 2 + 0) * D; const float* bb = p.in[17] + (size_t)(layer * 2 + 0) * D;
    const float* wc = p.in[18] + (size_t)layer * D * 8; const float* wf = p.in[19] + (size_t)layer * D * 64;
    unsigned* cnt = (unsigned*)(F.ws + WS_CTL) + CW_CNT + layer * 64;
    int* rowtok = (int*)(F.ws + WS_ROWTOK); float* rowgate = (float*)(F.ws + WS_ROWGATE); int* tokslot = (int*)(F.ws + WS_TOKSLOT);
    f32x4 gv[4], bv[4];
#pragma unroll
    for (int j = 0; j < 4; ++j) { gv[j] = ((const f32x4*)g)[F.lane + 64 * j]; bv[j] = ((const f32x4*)bb)[F.lane + 64 * j]; }
    for (int m = gw; m < T; m += NGW) {
        const f32x4* xr = (const f32x4*)(xin + (size_t)m * D) + F.lane; const f32x4* hr = (const f32x4*)(h32 + (size_t)m * D) + F.lane;
        f32x4 v[4]; float s = 0.f;
#pragma unroll
        for (int j = 0; j < 4; ++j) { v[j] = xr[64 * j] * ALPHA + hr[64 * j]; s += (v[j][0] + v[j][1]) + (v[j][2] + v[j][3]); }
        const float mean = wave_sum(s) * (1.0f / D); float s2 = 0.f;
#pragma unroll
        for (int j = 0; j < 4; ++j) { v[j] = v[j] - mean; s2 += (v[j][0] * v[j][0] + v[j][1] * v[j][1]) + (v[j][2] * v[j][2] + v[j][3] * v[j][3]); }
        const float rstd = 1.0f / sqrtf(wave_sum(s2) * (1.0f / D) + LN_EPS);
        f32x4* xo = (f32x4*)(x1 + (size_t)m * D) + F.lane; u32x2* xbo = (u32x2*)(x1b + (size_t)m * D) + F.lane;
#pragma unroll
        for (int j = 0; j < 4; ++j) { v[j] = v[j] * rstd * gv[j] + bv[j]; xo[64 * j] = v[j]; u32x2 w; w.x = pk2(v[j][0], v[j][1]); w.y = pk2(v[j][2], v[j][3]); xbo[64 * j] = w; }
        float lc[8];
#pragma unroll
        for (int c = 0; c < 8; ++c) lc[c] = 0.f;
#pragma unroll
        for (int j = 0; j < 4; ++j)
#pragma unroll
            for (int i = 0; i < 4; ++i) { const int k = 4 * F.lane + 256 * j + i; const f32x4 w0 = *(const f32x4*)(wc + (size_t)k * 8), w1 = *(const f32x4*)(wc + (size_t)k * 8 + 4); const float xv = v[j][i];
                lc[0] += xv * w0[0]; lc[1] += xv * w0[1]; lc[2] += xv * w0[2]; lc[3] += xv * w0[3]; lc[4] += xv * w1[0]; lc[5] += xv * w1[1]; lc[6] += xv * w1[2]; lc[7] += xv * w1[3]; }
#pragma unroll
        for (int c = 0; c < 8; ++c) lc[c] = wave_sum(lc[c]);
        int grp = 0; float lm = lc[0];
#pragma unroll
        for (int c = 1; c < 8; ++c) if (lc[c] > lm) { lm = lc[c]; grp = c; }
        float se = 0.f;
#pragma unroll
        for (int c = 0; c < 8; ++c) se += __expf(lc[c] - lm);
        const float p_grp = 1.0f / se;
        grp = __builtin_amdgcn_readfirstlane(grp);
        float lf[8];
#pragma unroll
        for (int c = 0; c < 8; ++c) lf[c] = 0.f;
#pragma unroll
        for (int j = 0; j < 4; ++j)
#pragma unroll
            for (int i = 0; i < 4; ++i) { const int k = 4 * F.lane + 256 * j + i; const f32x4 w0 = *(const f32x4*)(wf + (size_t)k * 64 + grp * 8), w1 = *(const f32x4*)(wf + (size_t)k * 64 + grp * 8 + 4); const float xv = v[j][i];
                lf[0] += xv * w0[0]; lf[1] += xv * w0[1]; lf[2] += xv * w0[2]; lf[3] += xv * w0[3]; lf[4] += xv * w1[0]; lf[5] += xv * w1[1]; lf[6] += xv * w1[2]; lf[7] += xv * w1[3]; }
#pragma unroll
        for (int c = 0; c < 8; ++c) lf[c] = wave_sum(lf[c]);
        int i1 = 0; float m1 = lf[0];
#pragma unroll
        for (int c = 1; c < 8; ++c) if (lf[c] > m1) { m1 = lf[c]; i1 = c; }
        int i2 = -1; float m2 = -3.0e38f;
#pragma unroll
        for (int c = 0; c < 8; ++c) if (c != i1 && lf[c] > m2) { m2 = lf[c]; i2 = c; }
        const float e2 = __expf(m2 - m1); const float g1 = p_grp / (1.0f + e2), g2 = p_grp * e2 / (1.0f + e2);
        if (F.lane == 0) {
            const int ea = grp * 8 + i1, eb = grp * 8 + i2;
            const unsigned pa = atomicAdd(cnt + ea, 1u); const unsigned pb = atomicAdd(cnt + eb, 1u);
            rowtok[(size_t)ea * T + pa] = m; rowgate[(size_t)ea * T + pa] = g1; rowtok[(size_t)eb * T + pb] = m; rowgate[(size_t)eb * T + pb] = g2;
            tokslot[2 * m] = (ea << 16) | (int)pa; tokslot[2 * m + 1] = (eb << 16) | (int)pb;
        }
    }
}
__device__ __forceinline__ void phase_ln2(Frame& F, const Params& p, int layer, const float* x1, const bf16_t* Y, float* xo32, bf16_t* xob) {
    const int gw = F.vcu * NWAVES + F.wave, NGW = F.G * NWAVES;
    const float* g = p.in[16] + (size_t)(layer * 2 + 1) * D; const float* bb = p.in[17] + (size_t)(layer * 2 + 1) * D;
    const int* tokslot = (const int*)(F.ws + WS_TOKSLOT); const LAS int* offL = (const LAS int*)(F.lds + LCTL_OFF + LC_OFF);
    f32x4 gv[4], bv[4];
#pragma unroll
    for (int j = 0; j < 4; ++j) { gv[j] = ((const f32x4*)g)[F.lane + 64 * j]; bv[j] = ((const f32x4*)bb)[F.lane + 64 * j]; }
    for (int m = gw; m < T; m += NGW) {
        const int sa = tokslot[2 * m], sb = tokslot[2 * m + 1];
        const int ra = offL[sa >> 16] + (sa & 0xffff), rb = offL[sb >> 16] + (sb & 0xffff);
        const f32x4* xr = (const f32x4*)(x1 + (size_t)m * D) + F.lane; const u32x2* ya = (const u32x2*)(Y + (size_t)ra * D) + F.lane; const u32x2* yb = (const u32x2*)(Y + (size_t)rb * D) + F.lane;
        f32x4 v[4]; float s = 0.f;
#pragma unroll
        for (int j = 0; j < 4; ++j) { const u32x2 a = ya[64 * j], b = yb[64 * j]; const f32x4 hv = (f32x4){bflo(a.x) + bflo(b.x), bfhi(a.x) + bfhi(b.x), bflo(a.y) + bflo(b.y), bfhi(a.y) + bfhi(b.y)};
            v[j] = xr[64 * j] * ALPHA + hv; s += (v[j][0] + v[j][1]) + (v[j][2] + v[j][3]); }
        const float mean = wave_sum(s) * (1.0f / D); float s2 = 0.f;
#pragma unroll
        for (int j = 0; j < 4; ++j) { v[j] = v[j] - mean; s2 += (v[j][0] * v[j][0] + v[j][1] * v[j][1]) + (v[j][2] * v[j][2] + v[j][3] * v[j][3]); }
        const float rstd = 1.0f / sqrtf(wave_sum(s2) * (1.0f / D) + LN_EPS);
        f32x4* xo = (f32x4*)(xo32 + (size_t)m * D) + F.lane; u32x2* xbo = (u32x2*)(xob + (size_t)m * D) + F.lane;
#pragma unroll
        for (int j = 0; j < 4; ++j) { v[j] = v[j] * rstd * gv[j] + bv[j]; xo[64 * j] = v[j]; u32x2 w; w.x = pk2(v[j][0], v[j][1]); w.y = pk2(v[j][2], v[j][3]); xbo[64 * j] = w; }
    }
}

constexpr int PH_PER_LAYER = 9, NPH = 1 + 4 * PH_PER_LAYER;
__host__ __device__ constexpr bool phase_exists(int ph) {
    if (ph == 0) return true;
    const int layer = (ph - 1) / PH_PER_LAYER, loc = (ph - 1) % PH_PER_LAYER, kind = layer % 3;
    if (loc == 2 || loc == 3) return kind == 2;
    return true;
}

#define IN(k) (lo <= (k) && (k) < hi)
#define SEAM(k) do { if ((k) + 1 < hi) xcd_barrier(bar); } while (0)
template <int LAYER>
__device__ __forceinline__ void run_layer(Frame& F, const Params& p, const int lo, const int hi, const XcdBarrier& bar) {
    unsigned char* ws = F.ws;
        constexpr int layer = LAYER; constexpr int kind = layer % 3, jx = layer / 3; constexpr int pb = 1 + layer * PH_PER_LAYER;
        const float* xin32 = (layer == 0) ? p.in[0] : (const float*)(ws + WS_XB32);
        const bf16_t* xinb = (const bf16_t*)(ws + WS_XBBF);
        bf16_t* BIGb = (bf16_t*)(ws + WS_BIG); bf16_t* Ob = (bf16_t*)(ws + WS_O); float* H32 = (float*)(ws + WS_H32);
        bf16_t* PROJ = (bf16_t*)(ws + WS_MOE_Y);
        if (PHM(1) && IN(pb + 0)) {
            if constexpr (kind == 0) { pg8::DenseSched S; S.init(T, A_QKV, D, (const bf16_t*)(ws + WS_WA_IN) + (size_t)jx * A_QKV * D, F.G, (int)blockIdx.x); EpiBf16Plain E{BIGb, A_QKV, 0};
                pg8::gemm_phase(F.lds, (const char*)xinb, D, S, E); }
            else if constexpr (kind == 1) { pg8::DenseSched S; S.init(T, 4096, D, ws + WS_WB_IN, F.G, (int)blockIdx.x); EpiBf16Plain E{BIGb, 4096, 1};
                pg8::gemm_phase(F.lds, (const char*)xinb, D, S, E); }
            else { pg8::DenseSched S; S.init(T, 4096, D, ws + WS_WC_IN, F.G, (int)blockIdx.x); EpiBf16Plain E{PROJ, 4096, 0};
                pg8::gemm_phase(F.lds, (const char*)xinb, D, S, E); }
            SEAM(pb + 0);
        }
        if (PHM(2) && IN(pb + 1)) {
            if constexpr (kind == 0) phase_attn_naive(F, BIGb, Ob, p.in[1]);
            else if constexpr (kind == 1) phase_sgu_naive(F, BIGb, Ob, p.in[5], p.in[6], p.in[7], p.in[8]);
            else phase_delta_pre(F, p, PROJ, xin32);
            SEAM(pb + 1);
        }
        if constexpr (kind == 2) {
            if (PHM(3) && IN(pb + 2)) { phase_delta_scan(F, H32); SEAM(pb + 2); }
            if (PHM(4) && IN(pb + 3)) { phase_delta_gate(F, H32, PROJ, p.in[14], Ob); SEAM(pb + 3); }
        }
        if (PHM(5) && IN(pb + 4)) {
            if constexpr (kind == 0) { pg8::DenseSched S; S.init(T, D, D, (const bf16_t*)(ws + WS_WA_OUT) + (size_t)jx * D * D, F.G, (int)blockIdx.x); EpiF32Plain E{H32, D}; pg8::gemm_phase(F.lds, (const char*)Ob, D, S, E); }
            else if constexpr (kind == 1) { pg8::DenseSched S; S.init(T, D, B_W, ws + WS_WB_OUT, F.G, (int)blockIdx.x); EpiF32Plain E{H32, D}; pg8::gemm_phase(F.lds, (const char*)Ob, B_W, S, E); }
            else { pg8::DenseSched S; S.init(T, D, D, ws + WS_WC_OUT, F.G, (int)blockIdx.x); EpiF32Plain E{H32, D}; pg8::gemm_phase(F.lds, (const char*)Ob, D, S, E); }
            SEAM(pb + 4);
        }
        if (PHM(6) && IN(pb + 5)) { phase_ln1_route(F, p, layer, xin32, H32, (float*)(ws + WS_XA32), (bf16_t*)(ws + WS_XABF)); SEAM(pb + 5); }
        if (PHM(7) && IN(pb + 6)) {
            moe_tables(F, layer);
            MoeSched1 S; S.te = (const LAS int*)(F.lds + LCTL_OFF + LC_TE); S.tr = (const LAS int*)(F.lds + LCTL_OFF + LC_TR); S.tl = (const LAS int*)(F.lds + LCTL_OFF + LC_TL); S.cntL = (const LAS int*)(F.lds + LCTL_OFF + LC_CNT);
            S.nunits = *(const LAS int*)(F.lds + LCTL_OFF + LC_NT) * 4; S.G = F.G; S.c = (int)blockIdx.x; S.rowtok = (const int*)(ws + WS_ROWTOK); S.GU = (const char*)(ws + WS_GU) + (size_t)layer * 64 * 1024 * D * 2;
            EpiSwiglu E{(bf16_t*)(ws + WS_MOE_H)};
            pg8::gemm_phase(F.lds, (const char*)(ws + WS_XABF), D, S, E);
            SEAM(pb + 6);
        }
        if (PHM(8) && IN(pb + 7)) {
            moe_tables(F, layer);
            MoeSched2 S; S.te = (const LAS int*)(F.lds + LCTL_OFF + LC_TE); S.tr = (const LAS int*)(F.lds + LCTL_OFF + LC_TR); S.tl = (const LAS int*)(F.lds + LCTL_OFF + LC_TL);
            S.nunits = *(const LAS int*)(F.lds + LCTL_OFF + LC_NT) * 4; S.G = F.G; S.c = (int)blockIdx.x; S.DN = (const char*)(ws + WS_DN) + (size_t)layer * 64 * 1024 * MOE_H * 2;
            EpiDown E{(bf16_t*)(ws + WS_MOE_Y), (const float*)(ws + WS_ROWGATE), (const LAS int*)(F.lds + LCTL_OFF + LC_CNT)};
            pg8::gemm_phase(F.lds, (const char*)(ws + WS_MOE_H), MOE_H, S, E);
            SEAM(pb + 7);
        }
        if (PHM(9) && IN(pb + 8)) {
            moe_tables(F, layer);
            float* xo = (layer == 3) ? p.out : (float*)(ws + WS_XB32);
            phase_ln2(F, p, layer, (const float*)(ws + WS_XA32), (const bf16_t*)(ws + WS_MOE_Y), xo, (bf16_t*)(ws + WS_XBBF));
            SEAM(pb + 8);
        }
    }
#undef IN
#undef SEAM

__global__ void __launch_bounds__(NTHR, 2) mk_fwd(Params p) {
    extern __shared__ __attribute__((aligned(16))) unsigned char lds_raw[];
    Frame F;
    F.lds = (LAS unsigned char*)lds_raw;
    F.tid = threadIdx.x; F.lane = F.tid & 63; F.wave = __builtin_amdgcn_readfirstlane(F.tid >> 6);
    F.G = gridDim.x; { const int bx = blockIdx.x; F.vcu = (F.G % 8 == 0) ? (bx % 8) * (F.G / 8) + bx / 8 : bx; }
    F.ws = p.ws;
    unsigned char* ws = p.ws;
    for (int u = F.tid; u < (LDS_BYTES - LCTL_OFF) / 4; u += NTHR) ((LAS unsigned*)(F.lds + LCTL_OFF))[u] = 0u;
    __syncthreads();
    const int lo = p.ph_lo, hi = p.ph_hi;
    XcdBarrier bar; bar.bar = (unsigned*)(ws + WS_CTL) + CW_BAR; bar.x = 0; bar.st = nullptr;
    if (hi - lo > 1) bar = xcd_barrier_post((unsigned*)(ws + WS_CTL) + CW_BAR, (volatile LAS unsigned*)(F.lds + LCTL_OFF + LC_BARST));
#define IN(k) (lo <= (k) && (k) < hi)
#define SEAM(k) do { if ((k) + 1 < hi) xcd_barrier(bar); } while (0)

    if (PHM(0) && IN(0)) { phase_prologue(F, p); SEAM(0); }

    if (LYM(0)) run_layer<0>(F, p, lo, hi, bar);
    if (LYM(1)) run_layer<1>(F, p, lo, hi, bar);
    if (LYM(2)) run_layer<2>(F, p, lo, hi, bar);
    if (LYM(3)) run_layer<3>(F, p, lo, hi, bar);
#undef IN
#undef SEAM
}

extern "C" void kernel_launch(void* const* d_in, const int* in_sizes, int n_in, void* d_out, int out_size, void* d_ws, size_t ws_size, hipStream_t stream) {
    static int grid = 0;
    if (grid == 0) {
        if (n_in != 23 || out_size != T * D || ws_size < WS_END) { fprintf(stderr, "kernel_launch: unexpected shapes (n_in %d out %d ws %zu)\n", n_in, out_size, ws_size); grid = -1; return; }
        int dev = 0, cus = 0, per_cu = 0;
        if (hipGetDevice(&dev) != hipSuccess || hipDeviceGetAttribute(&cus, hipDeviceAttributeMultiprocessorCount, dev) != hipSuccess) { grid = -1; return; }
        if (hipFuncSetAttribute((const void*)mk_fwd, hipFuncAttributeMaxDynamicSharedMemorySize, LDS_BYTES) != hipSuccess) { fprintf(stderr, "kernel_launch: hipFuncSetAttribute failed\n"); grid = -1; return; }
        if (hipOccupancyMaxActiveBlocksPerMultiprocessor(&per_cu, (const void*)mk_fwd, NTHR, LDS_BYTES) != hipSuccess || per_cu < 1) { fprintf(stderr, "kernel_launch: occupancy query says %d\n", per_cu); }
        (void)hipGetLastError();
        grid = cus;
    }
    if (grid < 0) return;
    if (hipMemsetAsync((char*)d_ws + WS_CTL, 0, CTL_ZERO_BYTES, stream) != hipSuccess) return;
    Params p{};
    for (int i = 0; i < 23; ++i) p.in[i] = (const float*)d_in[i];
    p.out = (float*)d_out; p.ws = (unsigned char*)d_ws;
#if MK_MULTI
    for (int ph = 0; ph < NPH; ++ph) {
        if (!phase_exists(ph)) continue;
        p.ph_lo = ph; p.ph_hi = ph + 1;
        hipLaunchKernelGGL(mk_fwd, dim3(grid), dim3(NTHR), LDS_BYTES, stream, p);
    }
#else
    p.ph_lo = 0; p.ph_hi = NPH;
    hipLaunchKernelGGL(mk_fwd, dim3(grid), dim3(NTHR), LDS_BYTES, stream, p);
#endif
}
```

```cpp
#include <hip/hip_runtime.h>
#include <cstdio>
#include <cstdint>

#ifndef MK_MULTI
#define MK_MULTI 0
#endif

#ifndef PH_MASK
#define PH_MASK 0xFFFF
#endif
#define PHM(b) ((PH_MASK >> (b)) & 1)
#ifndef LY_MASK
#define LY_MASK 0xF
#endif
#define LYM(b) ((LY_MASK >> (b)) & 1)
#define GAS __attribute__((address_space(1)))
#define LAS __attribute__((address_space(3)))
typedef unsigned short bf16_t;
typedef short bf16x8 __attribute__((ext_vector_type(8)));
typedef float f32x4 __attribute__((ext_vector_type(4)));
typedef float f32x2 __attribute__((ext_vector_type(2)));
typedef unsigned u32x4 __attribute__((ext_vector_type(4)));
typedef unsigned u32x2 __attribute__((ext_vector_type(2)));

constexpr int D = 1024, BATCH = 4, SEQ = 4096, T = BATCH * SEQ;
constexpr int NWAVES = 8, NTHR = 512;
constexpr int A_QKV = 9216;
constexpr int B_W = 2048;
constexpr int C_IN = 4112;
constexpr int NEXP = 64, MOE_H = 512;
constexpr float LN_EPS = 1e-5f, RMS_EPS = 1e-6f;
constexpr float ALPHA = 1.681792830507429f;

constexpr size_t MiB = 1u << 20;
constexpr size_t WS_CTL = 0, CTL_ZERO_BYTES = 1 * MiB;
constexpr size_t WS_WA_IN = 2 * MiB, WS_WA_OUT = 38 * MiB, WS_WB_IN = 42 * MiB, WS_WB_OUT = 50 * MiB, WS_WC_IN = 54 * MiB, WS_WC_OUT = 62 * MiB;
constexpr size_t WS_GU = 64 * MiB, WS_DN = 576 * MiB;
constexpr size_t WS_BIG = 832 * MiB;
constexpr size_t WS_MOE_Y = 1120 * MiB, WS_MOE_H = 1216 * MiB;
constexpr size_t WS_O = 1264 * MiB, WS_H32 = 1328 * MiB, WS_XA32 = 1392 * MiB, WS_XB32 = 1456 * MiB, WS_XABF = 1520 * MiB, WS_XBBF = 1552 * MiB;
constexpr size_t WS_ROWTOK = 1584 * MiB, WS_ROWGATE = 1588 * MiB, WS_TOKSLOT = 1592 * MiB, WS_END = 1600 * MiB;
constexpr size_t DP_WV = 0, DP_KC = 64 * MiB, DP_QG = 128 * MiB, DP_KD = 192 * MiB, DP_IN = 256 * MiB;
constexpr int CW_BAR = 4096, CW_CNT = 16384;

constexpr int SCR_BYTES = 139264;
constexpr int LCTL_OFF = SCR_BYTES;
constexpr int LDS_BYTES = 147456;
constexpr int LC_BARST = 0;
constexpr int LC_CNT = 64;
constexpr int LC_OFF = 320;
constexpr int LC_NT = 592;
constexpr int LC_TE = 640;
constexpr int LC_TR = 1408;
constexpr int LC_TL = 2176;
constexpr int LC_F0 = 3072;
constexpr int LC_F1 = 3584;
constexpr int LC_F2 = 4096;
constexpr int LC_F3 = 4608;

__device__ __forceinline__ unsigned f2bf(float f) { unsigned u = __builtin_bit_cast(unsigned, f); return (u + 0x7fffu + ((u >> 16) & 1u)) >> 16; }
__device__ __forceinline__ unsigned pk2(float lo, float hi) { return f2bf(lo) | (f2bf(hi) << 16); }
__device__ __forceinline__ float bflo(unsigned w) { return __builtin_bit_cast(float, w << 16); }
__device__ __forceinline__ float bfhi(unsigned w) { return __builtin_bit_cast(float, w & 0xffff0000u); }
__device__ __forceinline__ float bf1(bf16_t h) { return __builtin_bit_cast(float, ((unsigned)h) << 16); }
__device__ __forceinline__ float wave_sum(float v) {
#pragma unroll
    for (int o = 1; o < 64; o <<= 1) v += __shfl_xor(v, o);
    return v;
}
__device__ __forceinline__ float sigmoidf_(float x) { return 1.0f / (1.0f + __expf(-x)); }
__device__ __forceinline__ float siluf_(float x) { return x / (1.0f + __expf(-x)); }
__device__ __forceinline__ float gelu_tanh(float x) { const float u = 0.7978845608028654f * (x + 0.044715f * x * x * x); return x / (1.0f + __expf(-2.0f * u)); }
#define LDS_WAIT() asm volatile("s_waitcnt lgkmcnt(0)" ::: "memory")

#define XB_TMO      128
#define XB_XCNT(j)  (256  + 64 * (j))
#define XB_XSUB(j)  (1280 + 64 * (j))
#define XB_XGEN(j)  (2304 + 64 * (j))
#define XB_TOP      3328
#define XB_TOPGEN   3392
#define XCD_BAR_WORDS 3456
#define XB_SPIN_CAP (1u << 18)

__device__ __forceinline__ unsigned xb_ld(unsigned* p)              { return __hip_atomic_load(p, __ATOMIC_RELAXED, __HIP_MEMORY_SCOPE_AGENT); }
__device__ __forceinline__ unsigned xb_add(unsigned* p, unsigned v) { return __hip_atomic_fetch_add(p, v, __ATOMIC_RELAXED, __HIP_MEMORY_SCOPE_AGENT); }
__device__ __forceinline__ unsigned xb_xcc_id() { return (unsigned)__builtin_amdgcn_s_getreg((3 << 11) | 20) & 0xFu; }
#define XB_SPIN(cond, bar) do { unsigned _sp = 0; while (cond) { __builtin_amdgcn_s_sleep(1); \
    if ((++_sp & 255u) == 0u) { if (xb_ld(&(bar)[XB_TMO])) break; if (_sp > XB_SPIN_CAP) { atomicAdd(&(bar)[XB_TMO], 1u); break; } } } } while (0)

struct XcdBarrier { unsigned* bar; unsigned x; volatile LAS unsigned* st; };

__device__ __forceinline__ XcdBarrier xcd_barrier_post(unsigned* bar, volatile LAS unsigned* st) {
    XcdBarrier b; b.bar = bar; b.x = xb_xcc_id(); b.st = st;
    if (threadIdx.x == 0) (void)xb_add(&bar[XB_XCNT(b.x)], 1u);
    return b;
}
__device__ __forceinline__ void xcd_barrier_complete(unsigned* bar, unsigned x, unsigned& nloc, unsigned& nx) {
    const unsigned G = gridDim.x * gridDim.y * gridDim.z;
    unsigned sum, cnt, mine, sp = 0u;
    for (;;) {
        sum = 0u; cnt = 0u; mine = 0u;
#pragma unroll
        for (unsigned j = 0; j < 16; ++j) { const unsigned c = xb_ld(&bar[XB_XCNT(j)]); sum += c; cnt += (c > 0u) ? 1u : 0u; mine = (j == x) ? c : mine; }
        if (sum == G) break;
        __builtin_amdgcn_s_sleep(1);
        if ((++sp & 255u) == 0u) { if (xb_ld(&bar[XB_TMO])) break; if (sp > XB_SPIN_CAP) { atomicAdd(&bar[XB_TMO], 1u); break; } }
    }
    nloc = mine > 0u ? mine : 1u; nx = cnt > 0u ? cnt : 1u;
}
__device__ __forceinline__ void xcd_barrier(const XcdBarrier& b) {
    asm volatile("s_waitcnt vmcnt(0)" ::: "memory");
    __syncthreads();
    if (threadIdx.x == 0) {
        unsigned* bar = b.bar;
        __builtin_amdgcn_s_waitcnt(0);
        unsigned nloc = b.st[0], nx = b.st[1];
        if (nloc == 0u) { xcd_barrier_complete(bar, b.x, nloc, nx); b.st[0] = nloc; b.st[1] = nx; }
        const unsigned old = xb_add(&bar[XB_XSUB(b.x)], 1u);
        const unsigned gen = old / nloc;
        if (old + 1u == (gen + 1u) * nloc) {
            __builtin_amdgcn_fence(__ATOMIC_RELEASE, "agent");
            asm volatile("s_waitcnt vmcnt(0)" ::: "memory");
            const unsigned og = xb_add(&bar[XB_TOP], 1u);
            const unsigned tg = og / nx;
            if (og + 1u == (tg + 1u) * nx) xb_add(&bar[XB_TOPGEN], 1u);
            else XB_SPIN(xb_ld(&bar[XB_TOPGEN]) == tg, bar);
            __builtin_amdgcn_fence(__ATOMIC_ACQUIRE, "agent");
            xb_add(&bar[XB_XGEN(b.x)], 1u);
            asm volatile("s_waitcnt vmcnt(0)" ::: "memory");
        } else {
            XB_SPIN(xb_ld(&bar[XB_XGEN(b.x)]) == gen, bar);
            __builtin_amdgcn_fence(__ATOMIC_ACQUIRE, "agent");
            asm volatile("s_waitcnt vmcnt(0)" ::: "memory");
        }
    }
    __syncthreads();
}

namespace pg8 {
constexpr int BM = 256, BK = 64, HALF = 128, HTB = HALF * BK * 2, STAGE_BYTES = 8 * HTB;
__device__ __forceinline__ int lds_byte(int r, int c) { const int st = (r >> 4) * 2 + (c >> 5), rr = r & 15, cc = c & 31, ob = rr * 64 + cc * 2; return st * 1024 + (ob ^ (((ob >> 9) & 1) << 5)); }
__device__ __forceinline__ void stage_rc(int b, int& R, int& C) { const int st = b / 1024, sb = b % 1024, swz = sb ^ (((sb >> 9) & 1) << 5); R = (st >> 1) * 16 + swz / 64; C = (st & 1) * 32 + (swz % 64) / 2; }
__device__ __forceinline__ int perm32(int rho) { const int n = rho >> 4, i = rho & 15; return 8 * (i >> 2) + 4 * n + (i & 3); }
struct Unit { int pm, pn, ex, r0, l0; };
__device__ __forceinline__ unsigned cvt_pk_bf16(float lo, float hi) { unsigned r; asm volatile("v_cvt_pk_bf16_f32 %0, %1, %2" : "=v"(r) : "v"(lo), "v"(hi)); return r; }

template <class Epi, class Sched>
__device__ __forceinline__ void gemm_phase(LAS unsigned char* lds, const char* Abase, const int K, const Sched& S, const Epi& E) {
    const int tid = threadIdx.x, wid = __builtin_amdgcn_readfirstlane(tid >> 6), lane = tid & 63, wr = wid >> 2, wc = wid & 3, fr = lane & 15, fq = lane >> 4;
    const int nt = K / BK;
    int Rr[2], Cc2[2]; unsigned voffB[2];
#pragma unroll
    for (int i = 0; i < 2; ++i) { int R, C; stage_rc(tid * 16 + i * 8192, R, C); const int Rb = Epi::PERM ? ((R & ~31) + perm32(R & 31)) : R;
        Rr[i] = R; Cc2[i] = C * 2; voffB[i] = (unsigned)(Rb * K + C) * 2u; }
    const size_t kstep = (size_t)(BK * 2);
    const size_t hstep = (size_t)HALF * K * 2;
    const unsigned ldsw = (unsigned)wid * 1024u;
    const int aoff = lds_byte(wr * 64 + fr, fq * 8), boff = lds_byte(wc * 32 + fr, fq * 8);
#define PG8_SA(b, h) (((b) * 2 + (h)) * HTB)
#define PG8_SB(b, h) ((4 + (b) * 2 + (h)) * HTB)
#define PG8_STAGE2(bufoff, gbase, v0, v1) do { \
        __builtin_amdgcn_global_load_lds((const unsigned*)((const char*)(gbase) + (v0)), (LAS unsigned*)(lds + (bufoff) + ldsw), 16, 0, 0); \
        __builtin_amdgcn_global_load_lds((const unsigned*)((const char*)(gbase) + (v1)), (LAS unsigned*)(lds + (bufoff) + ldsw + 8192), 16, 0, 0); } while (0)
#define PG8_STAGEB(bufoff, gbase) PG8_STAGE2(bufoff, gbase, voffB[0], voffB[1])
#define PG8_LDA(dst, b, h) do { _Pragma("unroll") for (int m = 0; m < 4; ++m) _Pragma("unroll") for (int k = 0; k < 2; ++k) dst[m][k] = *(const LAS bf16x8*)(lds + PG8_SA(b, h) + aoff + m * 2048 + k * 1024); } while (0)
#define PG8_LDB(dst, b, h) do { _Pragma("unroll") for (int n = 0; n < 2; ++n) _Pragma("unroll") for (int k = 0; k < 2; ++k) dst[n][k] = *(const LAS bf16x8*)(lds + PG8_SB(b, h) + boff + n * 2048 + k * 1024); } while (0)
#define PG8_MMA(ai, bj, At, Bt) do { __builtin_amdgcn_s_setprio(1); _Pragma("unroll") for (int m = 0; m < 4; ++m) _Pragma("unroll") for (int n = 0; n < 2; ++n) _Pragma("unroll") for (int k = 0; k < 2; ++k) \
        acc[ai][bj][m][n] = __builtin_amdgcn_mfma_f32_16x16x32_bf16(Bt[n][k], At[m][k], acc[ai][bj][m][n], 0, 0, 0); __builtin_amdgcn_s_setprio(0); } while (0)
#define PG8_WAIT_V(n) asm volatile("s_waitcnt vmcnt(" #n ")" ::: "memory")
#define PG8_WAIT_L(n) asm volatile("s_waitcnt lgkmcnt(" #n ")" ::: "memory")
#define PG8_BAR __builtin_amdgcn_s_barrier()
#define PG8_SCHED __builtin_amdgcn_sched_barrier(0)
    Unit cur, nxt; int ui = 0;
    if (!S.next(0, cur)) return;
    f32x4 acc[2][2][4][2];
#pragma unroll
    for (int a = 0; a < 2; ++a)
#pragma unroll
        for (int b = 0; b < 2; ++b)
#pragma unroll
            for (int m = 0; m < 4; ++m)
#pragma unroll
                for (int n = 0; n < 2; ++n) acc[a][b][m][n] = (f32x4){0.f, 0.f, 0.f, 0.f};
    bf16x8 At[4][2], B0[2][2], B1[2][2];
    const char* cB = S.b_base(cur);
    unsigned va00 = S.a_off(cur, 0, Rr[0]) + Cc2[0], va01 = S.a_off(cur, 0, Rr[1]) + Cc2[1], va10 = S.a_off(cur, 1, Rr[0]) + Cc2[0], va11 = S.a_off(cur, 1, Rr[1]) + Cc2[1];
    unsigned vn00 = va00, vn01 = va01, vn10 = va10, vn11 = va11;
    PG8_STAGEB(PG8_SB(0, 0), cB); PG8_STAGE2(PG8_SA(0, 0), Abase, va00, va01); PG8_STAGEB(PG8_SB(0, 1), cB + hstep); PG8_STAGE2(PG8_SA(0, 1), Abase, va10, va11);
    if (wr == 1) PG8_BAR;
    PG8_WAIT_V(4); PG8_BAR;
    PG8_STAGEB(PG8_SB(1, 0), cB + kstep); PG8_STAGE2(PG8_SA(1, 0), Abase + kstep, va00, va01); PG8_STAGEB(PG8_SB(1, 1), cB + hstep + kstep);
    PG8_WAIT_V(6); PG8_BAR;
    for (;;) {
        const bool has_next = S.next(ui + 1, nxt);
        const char* nB = has_next ? S.b_base(nxt) : cB;
        for (int t = 0; t < nt; t += 2) {
            const bool last = (t == nt - 2);
            if (last) {
                if (has_next) { vn00 = S.a_off(nxt, 0, Rr[0]) + Cc2[0]; vn01 = S.a_off(nxt, 0, Rr[1]) + Cc2[1]; vn10 = S.a_off(nxt, 1, Rr[0]) + Cc2[0]; vn11 = S.a_off(nxt, 1, Rr[1]) + Cc2[1]; }
                else { vn00 = va00; vn01 = va01; vn10 = va10; vn11 = va11; }
            }
            const char* a1 = Abase + (size_t)(t + 1) * kstep;
            const char* a2 = last ? Abase : Abase + (size_t)(t + 2) * kstep; const char* b2 = last ? nB : cB + (size_t)(t + 2) * kstep;
            const char* a3 = a2 + kstep; const char* b3 = b2 + kstep;
            const unsigned o00 = last ? vn00 : va00, o01 = last ? vn01 : va01, o10 = last ? vn10 : va10, o11 = last ? vn11 : va11;
            PG8_LDB(B0, 0, 0); PG8_SCHED; PG8_LDA(At, 0, 0); PG8_STAGE2(PG8_SA(1, 1), a1, va10, va11);
            PG8_WAIT_L(8); PG8_BAR; PG8_WAIT_L(0); PG8_MMA(0, 0, At, B0); PG8_BAR; PG8_SCHED;
            PG8_LDB(B1, 0, 1); PG8_STAGEB(PG8_SB(0, 0), b2);
            PG8_BAR; PG8_WAIT_L(0); PG8_MMA(0, 1, At, B1); PG8_BAR;
            PG8_LDA(At, 0, 1); PG8_STAGE2(PG8_SA(0, 0), a2, o00, o01);
            PG8_BAR; PG8_WAIT_L(0); PG8_MMA(1, 0, At, B0); PG8_BAR; PG8_SCHED;
            PG8_STAGEB(PG8_SB(0, 1), b2 + hstep);
            PG8_WAIT_V(6); PG8_BAR; PG8_MMA(1, 1, At, B1); PG8_BAR;
            PG8_LDB(B0, 1, 0); PG8_SCHED; PG8_LDA(At, 1, 0); PG8_STAGE2(PG8_SA(0, 1), a2, o10, o11);
            PG8_WAIT_L(8); PG8_BAR; PG8_WAIT_L(0); PG8_MMA(0, 0, At, B0); PG8_BAR; PG8_SCHED;
            PG8_LDB(B1, 1, 1); PG8_STAGEB(PG8_SB(1, 0), b3);
            PG8_BAR; PG8_WAIT_L(0); PG8_MMA(0, 1, At, B1); PG8_BAR;
            PG8_LDA(At, 1, 1); PG8_STAGE2(PG8_SA(1, 0), a3, o00, o01);
            PG8_BAR; PG8_WAIT_L(0); PG8_MMA(1, 0, At, B0); PG8_BAR; PG8_SCHED;
            PG8_STAGEB(PG8_SB(1, 1), b3 + hstep);
            PG8_WAIT_V(6); PG8_BAR; PG8_MMA(1, 1, At, B1); PG8_BAR;
        }
        E(acc, cur, wr, wc, fr, fq);
        if (!has_next) break;
#pragma unroll
        for (int a = 0; a < 2; ++a)
#pragma unroll
            for (int b = 0; b < 2; ++b)
#pragma unroll
                for (int m = 0; m < 4; ++m)
#pragma unroll
                    for (int n = 0; n < 2; ++n) acc[a][b][m][n] = (f32x4){0.f, 0.f, 0.f, 0.f};
        cur = nxt; cB = nB; va00 = vn00; va01 = vn01; va10 = vn10; va11 = vn11; ++ui;
    }
    PG8_WAIT_V(0);
    if (wr == 0) PG8_BAR;
    PG8_BAR;
#undef PG8_SA
#undef PG8_SB
#undef PG8_STAGE2
#undef PG8_STAGEB
#undef PG8_LDA
#undef PG8_LDB
#undef PG8_MMA
#undef PG8_WAIT_V
#undef PG8_WAIT_L
#undef PG8_BAR
#undef PG8_SCHED
}

struct DenseSched {
    int nM, nN, nwg, G, c, K; const char* Bt;
    __device__ __forceinline__ void init(int M, int N, int K_, const void* Bt_, int G_, int c_) { nM = M / BM; nN = N / BM; nwg = nM * nN; G = G_; c = c_; K = K_; Bt = (const char*)Bt_; }
    __device__ __forceinline__ bool next(int i, Unit& u) const {
        const long L = (long)i * G + c; if (L >= nwg) return false;
        int wgid = (int)L; { const int q = nwg / 8, r = nwg % 8, xcd = wgid % 8, off = wgid / 8; wgid = (xcd < r ? xcd * (q + 1) : r * (q + 1) + (xcd - r) * q) + off; }
        const int nig = 8 * nN, gid = wgid / nig, fm = gid * 8, gsz = (nM - fm) < 8 ? (nM - fm) : 8;
        u.pm = fm + ((wgid % nig) % gsz); u.pn = (wgid % nig) / gsz; u.ex = 0; u.r0 = u.pm * BM; u.l0 = 0; return true;
    }
    __device__ __forceinline__ unsigned a_off(const Unit& u, int h, int R) const { return (unsigned)(u.pm * BM + h * HALF + R) * (unsigned)(K * 2); }
    __device__ __forceinline__ const char* b_base(const Unit& u) const { return Bt + (size_t)u.pn * BM * K * 2; }
};
}

struct Params { const float* in[23]; float* out; unsigned char* ws; int ph_lo, ph_hi; };

struct Frame {
    LAS unsigned char* lds;
    int tid, lane, wave, vcu, G;
    unsigned char* ws;
};

struct EpiBf16Plain {
    static constexpr bool PERM = true;
    bf16_t* O; int ldc; int act;
    __device__ __forceinline__ void operator()(const f32x4 (&acc)[2][2][4][2], const pg8::Unit& u, int wr, int wc, int fr, int fq) const {
        const int row0 = u.pm * 256 + wr * 64 + fr, col0 = u.pn * 256 + wc * 32 + 8 * fq;
#pragma unroll
        for (int ai = 0; ai < 2; ++ai)
#pragma unroll
            for (int m = 0; m < 4; ++m) { bf16_t* rowp = O + (size_t)(row0 + ai * 128 + m * 16) * ldc + col0;
#pragma unroll
                for (int bj = 0; bj < 2; ++bj) { f32x4 v0 = acc[ai][bj][m][0], v1 = acc[ai][bj][m][1];
                    if (act == 1) {
#pragma unroll
                        for (int j = 0; j < 4; ++j) { v0[j] = gelu_tanh(v0[j]); v1[j] = gelu_tanh(v1[j]); } }
                    u32x4 w; w.x = pg8::cvt_pk_bf16(v0[0], v0[1]); w.y = pg8::cvt_pk_bf16(v0[2], v0[3]); w.z = pg8::cvt_pk_bf16(v1[0], v1[1]); w.w = pg8::cvt_pk_bf16(v1[2], v1[3]);
                    *(u32x4*)(rowp + bj * 128) = w; } }
    }
};
struct EpiF32Plain {
    static constexpr bool PERM = false;
    float* C; int ldc;
    __device__ __forceinline__ void operator()(const f32x4 (&acc)[2][2][4][2], const pg8::Unit& u, int wr, int wc, int fr, int fq) const {
        const int row0 = u.pm * 256 + wr * 64 + fr, col0 = u.pn * 256 + wc * 32 + 4 * fq;
#pragma unroll
        for (int ai = 0; ai < 2; ++ai)
#pragma unroll
            for (int m = 0; m < 4; ++m) { float* rowp = C + (size_t)(row0 + ai * 128 + m * 16) * ldc + col0;
#pragma unroll
                for (int bj = 0; bj < 2; ++bj)
#pragma unroll
                    for (int n = 0; n < 2; ++n) *(f32x4*)(rowp + bj * 128 + n * 16) = acc[ai][bj][m][n]; }
    }
};
struct EpiSwiglu {
    static constexpr bool PERM = true;
    bf16_t* H;
    __device__ __forceinline__ void operator()(const f32x4 (&acc)[2][2][4][2], const pg8::Unit& u, int wr, int wc, int fr, int fq) const {
        const int row0 = u.r0 + wr * 64 + fr, col0 = u.pn * 128 + wc * 32 + 8 * fq;
#pragma unroll
        for (int ai = 0; ai < 2; ++ai)
#pragma unroll
            for (int m = 0; m < 4; ++m) { bf16_t* rowp = H + (size_t)(row0 + ai * 128 + m * 16) * MOE_H + col0;
                float o[8];
#pragma unroll
                for (int n = 0; n < 2; ++n)
#pragma unroll
                    for (int j = 0; j < 4; ++j) o[n * 4 + j] = siluf_(acc[ai][0][m][n][j]) * acc[ai][1][m][n][j];
                u32x4 w; w.x = pg8::cvt_pk_bf16(o[0], o[1]); w.y = pg8::cvt_pk_bf16(o[2], o[3]); w.z = pg8::cvt_pk_bf16(o[4], o[5]); w.w = pg8::cvt_pk_bf16(o[6], o[7]);
                *(u32x4*)rowp = w; }
    }
};
struct EpiDown {
    static constexpr bool PERM = true;
    bf16_t* Y; const float* rowgate; const LAS int* cntL;
    __device__ __forceinline__ void operator()(const f32x4 (&acc)[2][2][4][2], const pg8::Unit& u, int wr, int wc, int fr, int fq) const {
        const int lr0 = wr * 64 + fr, col0 = u.pn * 256 + wc * 32 + 8 * fq; const int cnt = cntL[u.ex];
#pragma unroll
        for (int ai = 0; ai < 2; ++ai)
#pragma unroll
            for (int m = 0; m < 4; ++m) { const int lr = lr0 + ai * 128 + m * 16; const int er = u.l0 + lr;
                const float gt = (er < cnt) ? rowgate[(size_t)u.ex * T + er] : 0.f;
                bf16_t* rowp = Y + (size_t)(u.r0 + lr) * D + col0;
#pragma unroll
                for (int bj = 0; bj < 2; ++bj) { const f32x4 v0 = acc[ai][bj][m][0] * gt, v1 = acc[ai][bj][m][1] * gt;
                    u32x4 w; w.x = pg8::cvt_pk_bf16(v0[0], v0[1]); w.y = pg8::cvt_pk_bf16(v0[2], v0[3]); w.z = pg8::cvt_pk_bf16(v1[0], v1[1]); w.w = pg8::cvt_pk_bf16(v1[2], v1[3]);
                    *(u32x4*)(rowp + bj * 128) = w; } }
    }
};

struct MoeSched1 {
    const LAS int *te, *tr, *tl, *cntL; int nunits, G, c; const int* rowtok; const char* GU;
    __device__ __forceinline__ bool next(int i, pg8::Unit& u) const { const int L = i * G + c; if (L >= nunits) return false; const int tlx = L >> 2; u.pn = L & 3; u.pm = 0; u.ex = te[tlx]; u.r0 = tr[tlx]; u.l0 = tl[tlx]; return true; }
    __device__ __forceinline__ unsigned a_off(const pg8::Unit& u, int h, int R) const { const int er = u.l0 + h * 128 + R; int tok = 0; if (er < cntL[u.ex]) tok = rowtok[(size_t)u.ex * T + er]; return (unsigned)tok * (unsigned)(D * 2); }
    __device__ __forceinline__ const char* b_base(const pg8::Unit& u) const { return GU + ((size_t)u.ex * 1024 + (size_t)u.pn * 256) * (size_t)(D * 2); }
};
struct MoeSched2 {
    const LAS int *te, *tr, *tl; int nunits, G, c; const char* DN;
    __device__ __forceinline__ bool next(int i, pg8::Unit& u) const { const int L = i * G + c; if (L >= nunits) return false; const int tlx = L >> 2; u.pn = L & 3; u.pm = 0; u.ex = te[tlx]; u.r0 = tr[tlx]; u.l0 = tl[tlx]; return true; }
    __device__ __forceinline__ unsigned a_off(const pg8::Unit& u, int h, int R) const { return (unsigned)(u.r0 + h * 128 + R) * (unsigned)(MOE_H * 2); }
    __device__ __forceinline__ const char* b_base(const pg8::Unit& u) const { return DN + ((size_t)u.ex * 1024 + (size_t)u.pn * 256) * (size_t)(MOE_H * 2); }
};

__device__ __forceinline__ void moe_tables(Frame& F, int layer) {
    LAS int* cntL = (LAS int*)(F.lds + LCTL_OFF + LC_CNT); LAS int* offL = (LAS int*)(F.lds + LCTL_OFF + LC_OFF); LAS int* ntL = (LAS int*)(F.lds + LCTL_OFF + LC_NT);
    LAS int* te = (LAS int*)(F.lds + LCTL_OFF + LC_TE); LAS int* tr = (LAS int*)(F.lds + LCTL_OFF + LC_TR); LAS int* tl = (LAS int*)(F.lds + LCTL_OFF + LC_TL);
    unsigned* cg = (unsigned*)(F.ws + WS_CTL) + CW_CNT + layer * 64;
    __syncthreads();
    if (F.tid < 64) cntL[F.tid] = (int)__hip_atomic_load(cg + F.tid, __ATOMIC_RELAXED, __HIP_MEMORY_SCOPE_AGENT);
    __syncthreads();
    if (F.tid == 0) {
        int o = 0, nt = 0;
        for (int e = 0; e < NEXP; ++e) { offL[e] = o; const int n = (cntL[e] + 255) >> 8;
            for (int t = 0; t < n; ++t) { if (nt < 192) { te[nt] = e; tr[nt] = o + 256 * t; tl[nt] = 256 * t; } ++nt; }
            o += n * 256; }
        offL[64] = o; ntL[0] = nt < 192 ? nt : 192;
    }
    __syncthreads();
}

__device__ __forceinline__ void tr_item(const float* W, int ldw, int nblk, bf16_t* WT, int Kd, int mode, LAS float* scr, int item, int lane) {
    const int kb = item / nblk, nb = item % nblk, k0 = 64 * kb, n0 = 32 * nb;
#pragma unroll 8
    for (int i = 0; i < 32; ++i) { const int kk = 2 * i + (lane >> 5); scr[kk * 33 + (lane & 31)] = W[(size_t)(k0 + kk) * ldw + n0 + (lane & 31)]; }
    LDS_WAIT(); asm volatile("" ::: "memory");
    const int c = lane & 7;
    int rbase = n0;
    if (mode == 1) rbase = (n0 >> 7) * 256 + (n0 & 127);
    if (mode == 2) rbase = (n0 >> 7) * 256 + 128 + (n0 & 127);
#pragma unroll
    for (int j = 0; j < 4; ++j) { const int n = (lane >> 3) + 8 * j; const LAS float* s = scr + (8 * c) * 33 + n;
        u32x4 o; o.x = pk2(s[0 * 33], s[1 * 33]); o.y = pk2(s[2 * 33], s[3 * 33]); o.z = pk2(s[4 * 33], s[5 * 33]); o.w = pk2(s[6 * 33], s[7 * 33]);
        *(u32x4*)(WT + (size_t)(rbase + n) * Kd + k0 + 8 * c) = o; }
    LDS_WAIT(); asm volatile("" ::: "memory");
}
__device__ __forceinline__ void phase_prologue(Frame& F, const Params& p) {
    LAS float* scr = (LAS float*)(F.lds + F.wave * 16384);
    const int gw = F.vcu * NWAVES + F.wave, NGW = F.G * NWAVES;
    constexpr int I_AIN = 16 * 288, I_AOUT = 512, I_BIN = 2048, I_BOUT = 1024, I_CIN = 2048, I_COUT = 512, I_ME = 256;
    constexpr int N_SMALL = 2 * I_AIN + 2 * I_AOUT + I_BIN + I_BOUT + I_CIN + I_COUT;
    constexpr int N_MOE = 4 * 64 * 3 * I_ME;
    unsigned char* ws = F.ws;
    for (int it = gw; it < N_SMALL + N_MOE; it += NGW) {
        int r = it;
        if (r < 2 * I_AIN) { const int j = r / I_AIN; r -= j * I_AIN; tr_item(p.in[2] + (size_t)j * D * A_QKV, A_QKV, 288, (bf16_t*)(ws + WS_WA_IN) + (size_t)j * A_QKV * D, D, 0, scr, r, F.lane); continue; } r -= 2 * I_AIN;
        if (r < 2 * I_AOUT) { const int j = r / I_AOUT; r -= j * I_AOUT; tr_item(p.in[3] + (size_t)j * D * D, D, 32, (bf16_t*)(ws + WS_WA_OUT) + (size_t)j * D * D, D, 0, scr, r, F.lane); continue; } r -= 2 * I_AOUT;
        if (r < I_BIN) { tr_item(p.in[4], 4096, 128, (bf16_t*)(ws + WS_WB_IN), D, 0, scr, r, F.lane); continue; } r -= I_BIN;
        if (r < I_BOUT) { tr_item(p.in[9], D, 32, (bf16_t*)(ws + WS_WB_OUT), B_W, 0, scr, r, F.lane); continue; } r -= I_BOUT;
        if (r < I_CIN) { tr_item(p.in[10], C_IN, 128, (bf16_t*)(ws + WS_WC_IN), D, 0, scr, r, F.lane); continue; } r -= I_CIN;
        if (r < I_COUT) { tr_item(p.in[15], D, 32, (bf16_t*)(ws + WS_WC_OUT), D, 0, scr, r, F.lane); continue; } r -= I_COUT;
        const int le = r / (3 * I_ME); r -= le * 3 * I_ME;
        if (r < I_ME) { tr_item(p.in[20] + (size_t)le * D * MOE_H, MOE_H, 16, (bf16_t*)(ws + WS_GU) + (size_t)le * 1024 * D, D, 1, scr, r, F.lane); continue; } r -= I_ME;
        if (r < I_ME) { tr_item(p.in[21] + (size_t)le * D * MOE_H, MOE_H, 16, (bf16_t*)(ws + WS_GU) + (size_t)le * 1024 * D, D, 2, scr, r, F.lane); continue; } r -= I_ME;
        tr_item(p.in[22] + (size_t)le * MOE_H * D, D, 32, (bf16_t*)(ws + WS_DN) + (size_t)le * 1024 * MOE_H, MOE_H, 0, scr, r, F.lane);
    }
    const float* x = p.in[0]; bf16_t* xb = (bf16_t*)(ws + WS_XBBF);
    for (int m = gw; m < T; m += NGW) {
        const f32x4* xr = (const f32x4*)(x + (size_t)m * D) + F.lane; u32x2* o = (u32x2*)(xb + (size_t)m * D) + F.lane;
#pragma unroll
        for (int j = 0; j < 4; ++j) { const f32x4 v = xr[64 * j]; u32x2 w; w.x = pk2(v[0], v[1]); w.y = pk2(v[2], v[3]); o[64 * j] = w; }
    }
}

__device__ __forceinline__ int t5_bucket(int d) {
    if (d < 16) return d;
    return 16 + (d >= 22) + (d >= 30) + (d >= 40) + (d >= 54) + (d >= 73) + (d >= 99) + (d >= 134) + (d >= 182) + (d >= 246) + (d >= 332) + (d >= 450) + (d >= 609) + (d >= 825) + (d >= 1117) + (d >= 1513);
}
__device__ __forceinline__ void phase_attn_naive(Frame& F, const bf16_t* qkv, bf16_t* O, const float* rel_bias) {
    LAS float* tab = (LAS float*)F.lds;
    __syncthreads();
    for (int idx = F.tid; idx < 3 * 129 * 16; idx += NTHR) { const int g = idx / (129 * 16), j = (idx >> 4) % 129, h = idx & 15; const int dil = g == 0 ? 1 : (g == 1 ? 4 : 16);
        tab[idx] = rel_bias[t5_bucket(j * dil) * 16 + h]; }
    __syncthreads();
    for (int blk = F.vcu; blk < T / 16; blk += F.G) {
        const int tok = blk * 16 + (F.tid >> 5), h = (F.tid >> 1) & 15, hf = F.tid & 1; const int pos = tok & (SEQ - 1);
        float mx = -1e30f, l = 0.f; float o[32];
#pragma unroll
        for (int d = 0; d < 32; ++d) o[d] = 0.f;
        for (int g = 0; g < 3; ++g) {
            const int dil = g == 0 ? 1 : (g == 1 ? 4 : 16);
            const bf16_t* qp = qkv + (size_t)tok * A_QKV + g * 3072 + h * 64 + hf * 32;
            float q[32];
#pragma unroll
            for (int c = 0; c < 4; ++c) { const u32x4 w = *(const u32x4*)(qp + 8 * c);
                q[8 * c + 0] = bflo(w.x) * 0.125f; q[8 * c + 1] = bfhi(w.x) * 0.125f; q[8 * c + 2] = bflo(w.y) * 0.125f; q[8 * c + 3] = bfhi(w.y) * 0.125f;
                q[8 * c + 4] = bflo(w.z) * 0.125f; q[8 * c + 5] = bfhi(w.z) * 0.125f; q[8 * c + 6] = bflo(w.w) * 0.125f; q[8 * c + 7] = bfhi(w.w) * 0.125f; }
            const int lq = pos / dil; const int nk = lq < 128 ? lq : 128;
            for (int j = 0; j <= nk; ++j) {
                const bf16_t* kp = qkv + (size_t)(tok - j * dil) * A_QKV + g * 3072 + 1024 + h * 64 + hf * 32; const bf16_t* vp = kp + 1024;
                float s = 0.f;
#pragma unroll
                for (int c = 0; c < 4; ++c) { const u32x4 w = *(const u32x4*)(kp + 8 * c);
                    s += q[8 * c + 0] * bflo(w.x) + q[8 * c + 1] * bfhi(w.x) + q[8 * c + 2] * bflo(w.y) + q[8 * c + 3] * bfhi(w.y)
                       + q[8 * c + 4] * bflo(w.z) + q[8 * c + 5] * bfhi(w.z) + q[8 * c + 6] * bflo(w.w) + q[8 * c + 7] * bfhi(w.w); }
                s += __shfl_xor(s, 1);
                s += tab[(g * 129 + j) * 16 + h];
                const float mn = fmaxf(mx, s); const float a = __expf(mx - mn), pp = __expf(s - mn); mx = mn; l = l * a + pp;
#pragma unroll
                for (int c = 0; c < 4; ++c) { const u32x4 w = *(const u32x4*)(vp + 8 * c);
                    o[8 * c + 0] = o[8 * c + 0] * a + pp * bflo(w.x); o[8 * c + 1] = o[8 * c + 1] * a + pp * bfhi(w.x); o[8 * c + 2] = o[8 * c + 2] * a + pp * bflo(w.y); o[8 * c + 3] = o[8 * c + 3] * a + pp * bfhi(w.y);
                    o[8 * c + 4] = o[8 * c + 4] * a + pp * bflo(w.z); o[8 * c + 5] = o[8 * c + 5] * a + pp * bfhi(w.z); o[8 * c + 6] = o[8 * c + 6] * a + pp * bflo(w.w); o[8 * c + 7] = o[8 * c + 7] * a + pp * bfhi(w.w); }
            }
        }
        const float il = 1.0f / l; bf16_t* op = O + (size_t)tok * D + h * 64 + hf * 32;
#pragma unroll
        for (int c = 0; c < 4; ++c) { u32x4 w; w.x = pk2(o[8 * c] * il, o[8 * c + 1] * il); w.y = pk2(o[8 * c + 2] * il, o[8 * c + 3] * il); w.z = pk2(o[8 * c + 4] * il, o[8 * c + 5] * il); w.w = pk2(o[8 * c + 6] * il, o[8 * c + 7] * il);
            *(u32x4*)(op + 8 * c) = w; }
    }
}

__device__ __forceinline__ void phase_sgu_naive(Frame& F, const bf16_t* z, bf16_t* O2, const float* gam, const float* bet, const float* w_s, const float* b_s) {
    LAS float* Vs = (LAS float*)F.lds;
    LAS float* Ws = (LAS float*)(F.lds + 65536);
    LAS float* mu = (LAS float*)(F.lds + LCTL_OFF + LC_F0); LAS float* rs = (LAS float*)(F.lds + LCTL_OFF + LC_F1);
    for (int u = F.vcu; u < 256; u += F.G) {
        const int chunk = u >> 1, gh = u & 1; const int tok0 = chunk * 128;
        __syncthreads();
        for (int r = F.wave; r < 128; r += NWAVES) {
            const bf16_t* vp = z + (size_t)(tok0 + r) * 4096 + 2048; float v[32]; float s = 0.f;
#pragma unroll
            for (int i = 0; i < 4; ++i) { const u32x4 w = *(const u32x4*)(vp + F.lane * 8 + 512 * i);
                v[8 * i + 0] = bflo(w.x); v[8 * i + 1] = bfhi(w.x); v[8 * i + 2] = bflo(w.y); v[8 * i + 3] = bfhi(w.y); v[8 * i + 4] = bflo(w.z); v[8 * i + 5] = bfhi(w.z); v[8 * i + 6] = bflo(w.w); v[8 * i + 7] = bfhi(w.w); }
#pragma unroll
            for (int i = 0; i < 32; ++i) s += v[i];
            const float mean = wave_sum(s) * (1.0f / 2048.0f); float s2 = 0.f;
#pragma unroll
            for (int i = 0; i < 32; ++i) { const float d = v[i] - mean; s2 += d * d; }
            const float var = wave_sum(s2) * (1.0f / 2048.0f);
            if (F.lane == 0) { mu[r] = mean; rs[r] = 1.0f / sqrtf(var + LN_EPS); }
        }
        __syncthreads();
        for (int gg = 0; gg < 8; ++gg) {
            const int g = gh * 8 + gg;
            for (int i = 0; i < 32; ++i) { const int idx = F.tid + NTHR * i; const int s = idx >> 7, c = idx & 127;
                const float v = bf1(z[(size_t)(tok0 + s) * 4096 + 2048 + g * 128 + c]);
                Vs[idx] = (v - mu[s]) * rs[s] * gam[g * 128 + c] + bet[g * 128 + c];
                const int t = idx >> 7, s2 = idx & 127;
                Ws[t * 129 + s2] = (s2 <= t) ? w_s[(size_t)g * 16384 + idx] : 0.f; }
            __syncthreads();
            const int t = F.tid >> 2, c0 = (F.tid & 3) * 32;
            float acc[32];
#pragma unroll
            for (int i = 0; i < 32; ++i) acc[i] = 0.f;
            for (int s = 0; s <= t; ++s) { const float w = Ws[t * 129 + s];
#pragma unroll
                for (int i = 0; i < 32; ++i) acc[i] += w * Vs[s * 128 + c0 + i]; }
            const float bs = b_s[g * 128 + t];
            const bf16_t* up = z + (size_t)(tok0 + t) * 4096 + g * 128 + c0; bf16_t* op = O2 + (size_t)(tok0 + t) * B_W + g * 128 + c0;
#pragma unroll
            for (int c = 0; c < 4; ++c) { const u32x4 w = *(const u32x4*)(up + 8 * c); u32x4 o;
                o.x = pk2(bflo(w.x) * (acc[8 * c + 0] + bs), bfhi(w.x) * (acc[8 * c + 1] + bs)); o.y = pk2(bflo(w.y) * (acc[8 * c + 2] + bs), bfhi(w.y) * (acc[8 * c + 3] + bs));
                o.z = pk2(bflo(w.z) * (acc[8 * c + 4] + bs), bfhi(w.z) * (acc[8 * c + 5] + bs)); o.w = pk2(bflo(w.w) * (acc[8 * c + 6] + bs), bfhi(w.w) * (acc[8 * c + 7] + bs));
                *(u32x4*)(op + 8 * c) = o; }
            __syncthreads();
        }
    }
}

__device__ __forceinline__ void phase_delta_pre(Frame& F, const Params& p, const bf16_t* proj, const float* x32) {
    LAS float* Qs = (LAS float*)F.lds; LAS float* Ks = Qs + 64 * 129; LAS float* Vs = Ks + 64 * 129; LAS float* Ls = Vs + 64 * 129;
    LAS float* betaL = (LAS float*)(F.lds + LCTL_OFF + LC_F0); LAS float* gL = (LAS float*)(F.lds + LCTL_OFF + LC_F1); LAS float* gcL = (LAS float*)(F.lds + LCTL_OFF + LC_F2);
    const float* w_in = p.in[10]; const float* conv = p.in[11]; const float* a_log = p.in[12]; const float* dt_bias = p.in[13];
    float* WV = (float*)(F.ws + WS_BIG + DP_WV); float* KC = (float*)(F.ws + WS_BIG + DP_KC); float* QG = (float*)(F.ws + WS_BIG + DP_QG); float* KD = (float*)(F.ws + WS_BIG + DP_KD); float* IN = (float*)(F.ws + WS_BIG + DP_IN);
    float* EGL = (float*)(F.ws + WS_ROWTOK);
    for (int u = F.vcu; u < 2048; u += F.G) {
        const int b = u >> 9, h = (u >> 6) & 7, n = u & 63; const int ch = (b * 8 + h) * 64 + n; const int tok0 = b * SEQ + n * 64;
        __syncthreads();
        { float wb[16], wa[16];
#pragma unroll
          for (int j = 0; j < 4; ++j)
#pragma unroll
              for (int i = 0; i < 4; ++i) { const int k = 4 * F.lane + 256 * j + i; wb[4 * j + i] = w_in[(size_t)k * C_IN + 4096 + h]; wa[4 * j + i] = w_in[(size_t)k * C_IN + 4104 + h]; }
#pragma unroll 1
          for (int tt = 0; tt < 8; ++tt) { const int t = F.wave * 8 + tt; const f32x4* xr = (const f32x4*)(x32 + (size_t)(tok0 + t) * D) + F.lane; float sb = 0.f, sa = 0.f;
#pragma unroll
              for (int j = 0; j < 4; ++j) { const f32x4 v = xr[64 * j];
#pragma unroll
                  for (int i = 0; i < 4; ++i) { sb += v[i] * wb[4 * j + i]; sa += v[i] * wa[4 * j + i]; } }
              sb = wave_sum(sb); sa = wave_sum(sa);
              if (F.lane == 0) { betaL[t] = sigmoidf_(sb); const float xx = sa + dt_bias[h]; const float sp = xx > 20.f ? xx : log1pf(__expf(xx)); gL[t] = -__expf(a_log[h]) * sp; } }
        }
#pragma unroll 1
        for (int i = 0; i < 48; ++i) { const int idx = F.tid + NTHR * i; const int which = idx >> 13, t = (idx >> 7) & 63, c = idx & 127; const int col = which * 1024 + h * 128 + c;
            float acc = 0.f;
#pragma unroll
            for (int j = 0; j < 4; ++j) { const int pp = n * 64 + t - 3 + j; if (pp >= 0) acc += conv[j * 3072 + col] * bf1(proj[(size_t)(b * SEQ + pp) * 4096 + col]); }
            const float v = siluf_(acc);
            (which == 0 ? Qs : (which == 1 ? Ks : Vs))[t * 129 + c] = v; }
        __syncthreads();
        if (F.tid == 0) { float s = 0.f; for (int t = 0; t < 64; ++t) { s += gL[t]; gcL[t] = s; } }
#pragma unroll 1
        for (int rr = 0; rr < 16; ++rr) { const int row = F.wave * 16 + rr; LAS float* base = (row < 64 ? Qs + row * 129 : Ks + (row - 64) * 129);
            const float x0 = base[F.lane], x1 = base[F.lane + 64]; const float ss = wave_sum(x0 * x0 + x1 * x1); float sc = 1.0f / sqrtf(ss + RMS_EPS); if (row < 64) sc *= 0.08838834764831845f;
            base[F.lane] = x0 * sc; base[F.lane + 64] = x1 * sc; }
        __syncthreads();
#pragma unroll 1
        for (int i = 0; i < 8; ++i) { const int idx = F.tid + NTHR * i; const int c = idx >> 6, s = idx & 63; float kk = 0.f, qk = 0.f;
#pragma unroll 8
            for (int d = 0; d < 128; ++d) { const float ks = Ks[s * 129 + d]; kk += Ks[c * 129 + d] * ks; qk += Qs[c * 129 + d] * ks; }
            const float dec = __expf(gcL[c] - gcL[s]);
            Ls[c * 65 + s] = (s < c) ? betaL[c] * kk * dec : 0.f;
            IN[(size_t)ch * 4096 + idx] = (s <= c) ? qk * dec : 0.f; }
#pragma unroll 1
        for (int i = 0; i < 16; ++i) { const int idx = F.tid + NTHR * i; const int c = idx >> 7, d = idx & 127;
            QG[(size_t)ch * 8192 + idx] = Qs[c * 129 + d] * __expf(gcL[c]); KD[(size_t)ch * 8192 + idx] = Ks[c * 129 + d] * __expf(gcL[63] - gcL[c]); }
        if (F.tid == 0) EGL[ch] = __expf(gcL[63]);
        __syncthreads();
#pragma unroll 1
        for (int i = 0; i < 16; ++i) { const int idx = F.tid + NTHR * i; const int c = idx >> 7, d = idx & 127; Vs[c * 129 + d] *= betaL[c]; Ks[c * 129 + d] *= betaL[c] * __expf(gcL[c]); }
        __syncthreads();
        if (F.tid < 256) { const int col = F.tid & 127; LAS float* buf = F.tid < 128 ? Vs : Ks;
#pragma unroll 1
            for (int c = 1; c < 64; ++c) { float a = buf[c * 129 + col];
#pragma unroll 4
                for (int s = 0; s < c; ++s) a -= Ls[c * 65 + s] * buf[s * 129 + col]; buf[c * 129 + col] = a; }
            float* dst = (F.tid < 128 ? WV : KC) + (size_t)ch * 8192;
#pragma unroll 4
            for (int c = 0; c < 64; ++c) dst[c * 128 + col] = buf[c * 129 + col]; }
    }
}
__device__ __forceinline__ void phase_delta_scan(Frame& F, float* oraw) {
    LAS float* KCs = (LAS float*)F.lds; LAS float* QGs = KCs + 64 * 132; LAS float* KDs = QGs + 64 * 132; LAS float* INs = KDs + 64 * 132;
    LAS float* St = INs + 64 * 68; LAS float* WVs = St + 128 * 16; LAS float* VN = WVs + 64 * 16;
    const float* WV = (const float*)(F.ws + WS_BIG + DP_WV); const float* KC = (const float*)(F.ws + WS_BIG + DP_KC); const float* QG = (const float*)(F.ws + WS_BIG + DP_QG);
    const float* KD = (const float*)(F.ws + WS_BIG + DP_KD); const float* IN = (const float*)(F.ws + WS_BIG + DP_IN); const float* EGL = (const float*)(F.ws + WS_ROWTOK);
    for (int u = F.vcu; u < 256; u += F.G) {
        const int bh = u >> 3, dv0 = (u & 7) * 16; const int b = bh >> 3, h = bh & 7;
        __syncthreads();
        for (int i = F.tid; i < 128 * 16; i += NTHR) St[i] = 0.f;
        for (int n = 0; n < 64; ++n) {
            const int ch = bh * 64 + n;
            __syncthreads();
            for (int i = 0; i < 4; ++i) { const int idx = F.tid + NTHR * i; const int c = idx >> 5, d4 = (idx & 31) * 4;
                *(LAS f32x4*)(KCs + c * 132 + d4) = *(const f32x4*)(KC + (size_t)ch * 8192 + c * 128 + d4);
                *(LAS f32x4*)(QGs + c * 132 + d4) = *(const f32x4*)(QG + (size_t)ch * 8192 + c * 128 + d4);
                *(LAS f32x4*)(KDs + c * 132 + d4) = *(const f32x4*)(KD + (size_t)ch * 8192 + c * 128 + d4); }
            for (int i = 0; i < 2; ++i) { const int idx = F.tid + NTHR * i; const int c = idx >> 4, s4 = (idx & 15) * 4; *(LAS f32x4*)(INs + c * 68 + s4) = *(const f32x4*)(IN + (size_t)ch * 4096 + c * 64 + s4); }
            if (F.tid < 256) { const int c = F.tid >> 2, j4 = (F.tid & 3) * 4; *(LAS f32x4*)(WVs + c * 16 + j4) = *(const f32x4*)(WV + (size_t)ch * 8192 + c * 128 + dv0 + j4); }
            const float egl = EGL[ch];
            __syncthreads();
            const int c = F.tid >> 3, j0 = (F.tid & 7) * 2;
            { float a0 = WVs[c * 16 + j0], a1 = WVs[c * 16 + j0 + 1];
              for (int d = 0; d < 128; ++d) { const float kc = KCs[c * 132 + d]; a0 -= kc * St[d * 16 + j0]; a1 -= kc * St[d * 16 + j0 + 1]; }
              VN[c * 16 + j0] = a0; VN[c * 16 + j0 + 1] = a1; }
            __syncthreads();
            { float o0 = 0.f, o1 = 0.f;
              for (int d = 0; d < 128; ++d) { const float qg = QGs[c * 132 + d]; o0 += qg * St[d * 16 + j0]; o1 += qg * St[d * 16 + j0 + 1]; }
              for (int s = 0; s < 64; ++s) { const float a = INs[c * 68 + s]; o0 += a * VN[s * 16 + j0]; o1 += a * VN[s * 16 + j0 + 1]; }
              float* op = oraw + (size_t)(b * SEQ + n * 64 + c) * D + h * 128 + dv0 + j0; *(f32x2*)op = (f32x2){o0, o1}; }
            const int d = F.tid >> 2, q0 = (F.tid & 3) * 4;
            float s0 = St[d * 16 + q0] * egl, s1 = St[d * 16 + q0 + 1] * egl, s2 = St[d * 16 + q0 + 2] * egl, s3 = St[d * 16 + q0 + 3] * egl;
            for (int cc = 0; cc < 64; ++cc) { const float kd = KDs[cc * 132 + d]; s0 += kd * VN[cc * 16 + q0]; s1 += kd * VN[cc * 16 + q0 + 1]; s2 += kd * VN[cc * 16 + q0 + 2]; s3 += kd * VN[cc * 16 + q0 + 3]; }
            __syncthreads();
            St[d * 16 + q0] = s0; St[d * 16 + q0 + 1] = s1; St[d * 16 + q0 + 2] = s2; St[d * 16 + q0 + 3] = s3;
        }
    }
}
__device__ __forceinline__ void phase_delta_gate(Frame& F, const float* oraw, const bf16_t* proj, const float* norm_w, bf16_t* O) {
    const int gw = F.vcu * NWAVES + F.wave, NGW = F.G * NWAVES;
    for (int m = gw; m < T; m += NGW) {
        const f32x4* op = (const f32x4*)(oraw + (size_t)m * D + 16 * F.lane); float o[16];
#pragma unroll
        for (int i = 0; i < 4; ++i) { const f32x4 v = op[i]; o[4 * i] = v[0]; o[4 * i + 1] = v[1]; o[4 * i + 2] = v[2]; o[4 * i + 3] = v[3]; }
        float ss = 0.f;
#pragma unroll
        for (int i = 0; i < 16; ++i) ss += o[i] * o[i];
        ss += __shfl_xor(ss, 1); ss += __shfl_xor(ss, 2); ss += __shfl_xor(ss, 4);
        const float r = 1.0f / sqrtf(ss * (1.0f / 128.0f) + RMS_EPS);
        const bf16_t* zp = proj + (size_t)m * 4096 + 3072 + 16 * F.lane; const u32x4 z0 = *(const u32x4*)zp, z1 = *(const u32x4*)(zp + 8);
        const float zz[16] = {bflo(z0.x), bfhi(z0.x), bflo(z0.y), bfhi(z0.y), bflo(z0.z), bfhi(z0.z), bflo(z0.w), bfhi(z0.w), bflo(z1.x), bfhi(z1.x), bflo(z1.y), bfhi(z1.y), bflo(z1.z), bfhi(z1.z), bflo(z1.w), bfhi(z1.w)};
        const int cb = (16 * F.lane) & 127; float y[16];
#pragma unroll
        for (int i = 0; i < 16; ++i) y[i] = o[i] * r * norm_w[cb + i] * siluf_(zz[i]);
        u32x4 w0, w1; w0.x = pk2(y[0], y[1]); w0.y = pk2(y[2], y[3]); w0.z = pk2(y[4], y[5]); w0.w = pk2(y[6], y[7]); w1.x = pk2(y[8], y[9]); w1.y = pk2(y[10], y[11]); w1.z = pk2(y[12], y[13]); w1.w = pk2(y[14], y[15]);
        bf16_t* dst = O + (size_t)m * D + 16 * F.lane; *(u32x4*)dst = w0; *(u32x4*)(dst + 8) = w1;
    }
}

__device__ __forceinline__ void phase_ln1_route(Frame& F, const Params& p, int layer, const float* xin, const float* h32, float* x1, bf16_t* x1b) {
    const int gw = F.vcu * NWAVES + F.wave, NGW = F.G * NWAVES;
    const float* g = p.in[16] + (size_t)(layer * 2 + 0) * D; const float* bb = p.in[17] + (size_t)(layer * 2 + 0) * D;
    const float* wc = p.in[18] + (size_t)layer * D * 8; const float* wf = p.in[19] + (size_t)layer * D * 64;
    unsigned* cnt = (unsigned*)(F.ws + WS_CTL) + CW_CNT + layer * 64;
    int* rowtok = (int*)(F.ws + WS_ROWTOK); float* rowgate = (float*)(F.ws + WS_ROWGATE); int* tokslot = (int*)(F.ws + WS_TOKSLOT);
    f32x4 gv[4], bv[4];
#pragma unroll
    for (int j = 0; j < 4; ++j) { gv[j] = ((const f32x4*)g)[F.lane + 64 * j]; bv[j] = ((const f32x4*)bb)[F.lane + 64 * j]; }
    for (int m = gw; m < T; m += NGW) {
        const f32x4* xr = (const f32x4*)(xin + (size_t)m * D) + F.lane; const f32x4* hr = (const f32x4*)(h32 + (size_t)m * D) + F.lane;
        f32x4 v[4]; float s = 0.f;
#pragma unroll
        for (int j = 0; j < 4; ++j) { v[j] = xr[64 * j] * ALPHA + hr[64 * j]; s += (v[j][0] + v[j][1]) + (v[j][2] + v[j][3]); }
        const float mean = wave_sum(s) * (1.0f / D); float s2 = 0.f;
#pragma unroll
        for (int j = 0; j < 4; ++j) { v[j] = v[j] - mean; s2 += (v[j][0] * v[j][0] + v[j][1] * v[j][1]) + (v[j][2] * v[j][2] + v[j][3] * v[j][3]); }
        const float rstd = 1.0f / sqrtf(wave_sum(s2) * (1.0f / D) + LN_EPS);
        f32x4* xo = (f32x4*)(x1 + (size_t)m * D) + F.lane; u32x2* xbo = (u32x2*)(x1b + (size_t)m * D) + F.lane;
#pragma unroll
        for (int j = 0; j < 4; ++j) { v[j] = v[j] * rstd * gv[j] + bv[j]; xo[64 * j] = v[j]; u32x2 w; w.x = pk2(v[j][0], v[j][1]); w.y = pk2(v[j][2], v[j][3]); xbo[64 * j] = w; }
        float lc[8];
#pragma unroll
        for (int c = 0; c < 8; ++c) lc[c] = 0.f;
#pragma unroll
        for (int j = 0; j < 4; ++j)
#pragma unroll
            for (int i = 0; i < 4; ++i) { const int k = 4 * F.lane + 256 * j + i; const f32x4 w0 = *(const f32x4*)(wc + (size_t)k * 8), w1 = *(const f32x4*)(wc + (size_t)k * 8 + 4); const float xv = v[j][i];
                lc[0] += xv * w0[0]; lc[1] += xv * w0[1]; lc[2] += xv * w0[2]; lc[3] += xv * w0[3]; lc[4] += xv * w1[0]; lc[5] += xv * w1[1]; lc[6] += xv * w1[2]; lc[7] += xv * w1[3]; }
#pragma unroll
        for (int c = 0; c < 8; ++c) lc[c] = wave_sum(lc[c]);
        int grp = 0; float lm = lc[0];
#pragma unroll
        for (int c = 1; c < 8; ++c) if (lc[c] > lm) { lm = lc[c]; grp = c; }
        float se = 0.f;
#pragma unroll
        for (int c = 0; c < 8; ++c) se += __expf(lc[c] - lm);
        const float p_grp = 1.0f / se;
        grp = __builtin_amdgcn_readfirstlane(grp);
        float lf[8];
#pragma unroll
        for (int c = 0; c < 8; ++c) lf[c] = 0.f;
#pragma unroll
        for (int j = 0; j < 4; ++j)
#pragma unroll
            for (int i = 0; i < 4; ++i) { const int k = 4 * F.lane + 256 * j + i; const f32x4 w0 = *(const f32x4*)(wf + (size_t)k * 64 + grp * 8), w1 = *(const f32x4*)(wf + (size_t)k * 64 + grp * 8 + 4); const float xv = v[j][i];
                lf[0] += xv * w0[0]; lf[1] += xv * w0[1]; lf[2] += xv * w0[2]; lf[3] += xv * w0[3]; lf[4] += xv * w1[0]; lf[5] += xv * w1[1]; lf[6] += xv * w1[2]; lf[7] += xv * w1[3]; }
#pragma unroll
        for (int c = 0; c < 8; ++c) lf[c] = wave_sum(lf[c]);
        int i1 = 0; float m1 = lf[0];
#pragma unroll
        for (int c = 1; c < 8; ++c) if (lf[c] > m1) { m1 = lf[c]; i1 = c; }
        int i2 = -1; float m2 = -3.0e38f;
#pragma unroll
        for (int c = 0; c < 8; ++c) if (c != i1 && lf[c] > m2) { m2 = lf[c]; i2 = c; }
        const float e2 = __expf(m2 - m1); const float g1 = p_grp / (1.0f + e2), g2 = p_grp * e2 / (1.0f + e2);
        if (F.lane == 0) {
            const int ea = grp * 8 + i1, eb = grp * 8 + i2;
            const unsigned pa = atomicAdd(cnt + ea, 1u); const unsigned pb = atomicAdd(cnt + eb, 1u);
            rowtok[(size_t)ea * T + pa] = m; rowgate[(size_t)ea * T + pa] = g1; rowtok[(size_t)eb * T + pb] = m; rowgate[(size_t)eb * T + pb] = g2;
            tokslot[2 * m] = (ea << 16) | (int)pa; tokslot[2 * m + 1] = (eb << 16) | (int)pb;
        }
    }
}
__device__ __forceinline__ void phase_ln2(Frame& F, const Params& p, int layer, const float* x1, const bf16_t* Y, float* xo32, bf16_t* xob) {
    const int gw = F.vcu * NWAVES + F.wave, NGW = F.G * NWAVES;
    const float* g = p.in[16] + (size_t)(layer * 2 + 1) * D; const float* bb = p.in[17] + (size_t)(layer * 2 + 1) * D;
    const int* tokslot = (const int*)(F.ws + WS_TOKSLOT); const LAS int* offL = (const LAS int*)(F.lds + LCTL_OFF + LC_OFF);
    f32x4 gv[4], bv[4];
#pragma unroll
    for (int j = 0; j < 4; ++j) { gv[j] = ((const f32x4*)g)[F.lane + 64 * j]; bv[j] = ((const f32x4*)bb)[F.lane + 64 * j]; }
    for (int m = gw; m < T; m += NGW) {
        const int sa = tokslot[2 * m], sb = tokslot[2 * m + 1];
        const int ra = offL[sa >> 16] + (sa & 0xffff), rb = offL[sb >> 16] + (sb & 0xffff);
        const f32x4* xr = (const f32x4*)(x1 + (size_t)m * D) + F.lane; const u32x2* ya = (const u32x2*)(Y + (size_t)ra * D) + F.lane; const u32x2* yb = (const u32x2*)(Y + (size_t)rb * D) + F.lane;
        f32x4 v[4]; float s = 0.f;
#pragma unroll
        for (int j = 0; j < 4; ++j) { const u32x2 a = ya[64 * j], b = yb[64 * j]; const f32x4 hv = (f32x4){bflo(a.x) + bflo(b.x), bfhi(a.x) + bfhi(b.x), bflo(a.y) + bflo(b.y), bfhi(a.y) + bfhi(b.y)};
            v[j] = xr[64 * j] * ALPHA + hv; s += (v[j][0] + v[j][1]) + (v[j][2] + v[j][3]); }
        const float mean = wave_sum(s) * (1.0f / D); float s2 = 0.f;
#pragma unroll
        for (int j = 0; j < 4; ++j) { v[j] = v[j] - mean; s2 += (v[j][0] * v[j][0] + v[j][1] * v[j][1]) + (v[j][2] * v[j][2] + v[j][3] * v[j][3]); }
        const float rstd = 1.0f / sqrtf(wave_sum(s2) * (1.0f / D) + LN_EPS);
        f32x4* xo = (f32x4*)(xo32 + (size_t)m * D) + F.lane; u32x2* xbo = (u32x2*)(xob + (size_t)m * D) + F.lane;
#pragma unroll
        for (int j = 0; j < 4; ++j) { v[j] = v[j] * rstd * gv[j] + bv[j]; xo[64 * j] = v[j]; u32x2 w; w.x = pk2(v[j][0], v[j][1]); w.y = pk2(v[j][2], v[j][3]); xbo[64 * j] = w; }
    }
}

constexpr int PH_PER_LAYER = 9, NPH = 1 + 4 * PH_PER_LAYER;
__host__ __device__ constexpr bool phase_exists(int ph) {
    if (ph == 0) return true;
    const int layer = (ph - 1) / PH_PER_LAYER, loc = (ph - 1) % PH_PER_LAYER, kind = layer % 3;
    if (loc == 2 || loc == 3) return kind == 2;
    return true;
}

#define IN(k) (lo <= (k) && (k) < hi)
#define SEAM(k) do { if ((k) + 1 < hi) xcd_barrier(bar); } while (0)
template <int LAYER>
__device__ __forceinline__ void run_layer(Frame& F, const Params& p, const int lo, const int hi, const XcdBarrier& bar) {
    unsigned char* ws = F.ws;
        constexpr int layer = LAYER; constexpr int kind = layer % 3, jx = layer / 3; constexpr int pb = 1 + layer * PH_PER_LAYER;
        const float* xin32 = (layer == 0) ? p.in[0] : (const float*)(ws + WS_XB32);
        const bf16_t* xinb = (const bf16_t*)(ws + WS_XBBF);
        bf16_t* BIGb = (bf16_t*)(ws + WS_BIG); bf16_t* Ob = (bf16_t*)(ws + WS_O); float* H32 = (float*)(ws + WS_H32);
        bf16_t* PROJ = (bf16_t*)(ws + WS_MOE_Y);
        if (PHM(1) && IN(pb + 0)) {
            if constexpr (kind == 0) { pg8::DenseSched S; S.init(T, A_QKV, D, (const bf16_t*)(ws + WS_WA_IN) + (size_t)jx * A_QKV * D, F.G, (int)blockIdx.x); EpiBf16Plain E{BIGb, A_QKV, 0};
                pg8::gemm_phase(F.lds, (const char*)xinb, D, S, E); }
            else if constexpr (kind == 1) { pg8::DenseSched S; S.init(T, 4096, D, ws + WS_WB_IN, F.G, (int)blockIdx.x); EpiBf16Plain E{BIGb, 4096, 1};
                pg8::gemm_phase(F.lds, (const char*)xinb, D, S, E); }
            else { pg8::DenseSched S; S.init(T, 4096, D, ws + WS_WC_IN, F.G, (int)blockIdx.x); EpiBf16Plain E{PROJ, 4096, 0};
                pg8::gemm_phase(F.lds, (const char*)xinb, D, S, E); }
            SEAM(pb + 0);
        }
        if (PHM(2) && IN(pb + 1)) {
            if constexpr (kind == 0) phase_attn_naive(F, BIGb, Ob, p.in[1]);
            else if constexpr (kind == 1) phase_sgu_naive(F, BIGb, Ob, p.in[5], p.in[6], p.in[7], p.in[8]);
            else phase_delta_pre(F, p, PROJ, xin32);
            SEAM(pb + 1);
        }
        if constexpr (kind == 2) {
            if (PHM(3) && IN(pb + 2)) { phase_delta_scan(F, H32); SEAM(pb + 2); }
            if (PHM(4) && IN(pb + 3)) { phase_delta_gate(F, H32, PROJ, p.in[14], Ob); SEAM(pb + 3); }
        }
        if (PHM(5) && IN(pb + 4)) {
            if constexpr (kind == 0) { pg8::DenseSched S; S.init(T, D, D, (const bf16_t*)(ws + WS_WA_OUT) + (size_t)jx * D * D, F.G, (int)blockIdx.x); EpiF32Plain E{H32, D}; pg8::gemm_phase(F.lds, (const char*)Ob, D, S, E); }
            else if constexpr (kind == 1) { pg8::DenseSched S; S.init(T, D, B_W, ws + WS_WB_OUT, F.G, (int)blockIdx.x); EpiF32Plain E{H32, D}; pg8::gemm_phase(F.lds, (const char*)Ob, B_W, S, E); }
            else { pg8::DenseSched S; S.init(T, D, D, ws + WS_WC_OUT, F.G, (int)blockIdx.x); EpiF32Plain E{H32, D}; pg8::gemm_phase(F.lds, (const char*)Ob, D, S, E); }
            SEAM(pb + 4);
        }
        if (PHM(6) && IN(pb + 5)) { phase_ln1_route(F, p, layer, xin32, H32, (float*)(ws + WS_XA32), (bf16_t*)(ws + WS_XABF)); SEAM(pb + 5); }
        if (PHM(7) && IN(pb + 6)) {
            moe_tables(F, layer);
            MoeSched1 S; S.te = (const LAS int*)(F.lds + LCTL_OFF + LC_TE); S.tr = (const LAS int*)(F.lds + LCTL_OFF + LC_TR); S.tl = (const LAS int*)(F.lds + LCTL_OFF + LC_TL); S.cntL = (const LAS int*)(F.lds + LCTL_OFF + LC_CNT);
            S.nunits = *(const LAS int*)(F.lds + LCTL_OFF + LC_NT) * 4; S.G = F.G; S.c = (int)blockIdx.x; S.rowtok = (const int*)(ws + WS_ROWTOK); S.GU = (const char*)(ws + WS_GU) + (size_t)layer * 64 * 1024 * D * 2;
            EpiSwiglu E{(bf16_t*)(ws + WS_MOE_H)};
            pg8::gemm_phase(F.lds, (const char*)(ws + WS_XABF), D, S, E);
            SEAM(pb + 6);
        }
        if (PHM(8) && IN(pb + 7)) {
            moe_tables(F, layer);
            MoeSched2 S; S.te = (const LAS int*)(F.lds + LCTL_OFF + LC_TE); S.tr = (const LAS int*)(F.lds + LCTL_OFF + LC_TR); S.tl = (const LAS int*)(F.lds + LCTL_OFF + LC_TL);
            S.nunits = *(const LAS int*)(F.lds + LCTL_OFF + LC_NT) * 4; S.G = F.G; S.c = (int)blockIdx.x; S.DN = (const char*)(ws + WS_DN) + (size_t)layer * 64 * 1024 * MOE_H * 2;
            EpiDown E{(bf16_t*)(ws + WS_MOE_Y), (const float*)(ws + WS_ROWGATE), (const LAS int*)(F.lds + LCTL_OFF + LC_CNT)};
            pg8::gemm_phase(F.lds, (const char*)(ws + WS_MOE_H), MOE_H, S, E);
            SEAM(pb + 7);
        }
        if (PHM(9) && IN(pb + 8)) {
            moe_tables(F, layer);
            float* xo = (layer == 3) ? p.out : (float*)(ws + WS_XB32);
            phase_ln2(F, p, layer, (const float*)(ws + WS_XA32), (const bf16_t*)(ws + WS_MOE_Y), xo, (bf16_t*)(ws + WS_XBBF));
            SEAM(pb + 8);
        }
    }
#undef IN
#undef SEAM

__global__ void __launch_bounds__(NTHR, 2) mk_fwd(Params p) {
    extern __shared__ __attribute__((aligned(16))) unsigned char lds_raw[];
    Frame F;
    F.lds = (LAS unsigned char*)lds_raw;
    F.tid = threadIdx.x; F.lane = F.tid & 63; F.wave = __builtin_amdgcn_readfirstlane(F.tid >> 6);
    F.G = gridDim.x; { const int bx = blockIdx.x; F.vcu = (F.G % 8 == 0) ? (bx % 8) * (F.G / 8) + bx / 8 : bx; }
    F.ws = p.ws;
    unsigned char* ws = p.ws;
    for (int u = F.tid; u < (LDS_BYTES - LCTL_OFF) / 4; u += NTHR) ((LAS unsigned*)(F.lds + LCTL_OFF))[u] = 0u;
    __syncthreads();
    const int lo = p.ph_lo, hi = p.ph_hi;
    XcdBarrier bar; bar.bar = (unsigned*)(ws + WS_CTL) + CW_BAR; bar.x = 0; bar.st = nullptr;
    if (hi - lo > 1) bar = xcd_barrier_post((unsigned*)(ws + WS_CTL) + CW_BAR, (volatile LAS unsigned*)(F.lds + LCTL_OFF + LC_BARST));
#define IN(k) (lo <= (k) && (k) < hi)
#define SEAM(k) do { if ((k) + 1 < hi) xcd_barrier(bar); } while (0)

    if (PHM(0) && IN(0)) { phase_prologue(F, p); SEAM(0); }

    if (LYM(0)) run_layer<0>(F, p, lo, hi, bar);
    if (LYM(1)) run_layer<1>(F, p, lo, hi, bar);
    if (LYM(2)) run_layer<2>(F, p, lo, hi, bar);
    if (LYM(3)) run_layer<3>(F, p, lo, hi, bar);
#undef IN
#undef SEAM
}

extern "C" void kernel_launch(void* const* d_in, const int* in_sizes, int n_in, void* d_out, int out_size, void* d_ws, size_t ws_size, hipStream_t stream) {
    static int grid = 0;
    if (grid == 0) {
        if (n_in != 23 || out_size != T * D || ws_size < WS_END) { fprintf(stderr, "kernel_launch: unexpected shapes (n_in %d out %d ws %zu)\n", n_in, out_size, ws_size); grid = -1; return; }
        int dev = 0, cus = 0, per_cu = 0;
        if (hipGetDevice(&dev) != hipSuccess || hipDeviceGetAttribute(&cus, hipDeviceAttributeMultiprocessorCount, dev) != hipSuccess) { grid = -1; return; }
        if (hipFuncSetAttribute((const void*)mk_fwd, hipFuncAttributeMaxDynamicSharedMemorySize, LDS_BYTES) != hipSuccess) { fprintf(stderr, "kernel_launch: hipFuncSetAttribute failed\n"); grid = -1; return; }
        if (hipOccupancyMaxActiveBlocksPerMultiprocessor(&per_cu, (const void*)mk_fwd, NTHR, LDS_BYTES) != hipSuccess || per_cu < 1) { fprintf(stderr, "kernel_launch: occupancy query says %d\n", per_cu); }
        (void)hipGetLastError();
        grid = cus;
    }
    if (grid < 0) return;
    if (hipMemsetAsync((char*)d_ws + WS_CTL, 0, CTL_ZERO_BYTES, stream) != hipSuccess) return;
    Params p{};
    for (int i = 0; i < 23; ++i) p.in[i] = (const float*)d_in[i];
    p.out = (float*)d_out; p.ws = (unsigned char*)d_ws;
#if MK_MULTI
    for (int ph = 0; ph < NPH; ++ph) {
        if (!phase_exists(ph)) continue;
        p.ph_lo = ph; p.ph_hi = ph + 1;
        hipLaunchKernelGGL(mk_fwd, dim3(grid), dim3(NTHR), LDS_BYTES, stream, p);
    }
#else
    p.ph_lo = 0; p.ph_hi = NPH;
    hipLaunchKernelGGL(mk_fwd, dim3(grid), dim3(NTHR), LDS_BYTES, stream, p);
#endif
}
```
